# Optimizing an MI355X kernel written in HIP

```python
import jax, jax.numpy as jnp
from jax import lax
import numpy as np

D_MODEL = 1024
BATCH = 8
SEQ = 4096
DEPTH = 2

CHUNK = 64
D_MIX = D_MODEL
A_WIDTH = D_MIX // 2
A_GROUPS = 8
A_GROUP_DIM = A_WIDTH // A_GROUPS
A_BLOCK = 128
B_WIDTH = D_MIX - A_WIDTH
B_HEADS = 4
B_HEAD_V = B_WIDTH // B_HEADS
B_HEAD_K = B_HEAD_V // 2
B_KEY = B_HEADS * B_HEAD_K
GATE_RANK = 16
GATE_NORM = 16.0
D_FF = 2816
EPS = 1e-6
SPLITS = (A_WIDTH, 2 * A_WIDTH, 2 * A_WIDTH + B_KEY, 2 * A_WIDTH + 2 * B_KEY,
          2 * A_WIDTH + 2 * B_KEY + B_WIDTH, 2 * A_WIDTH + 2 * B_KEY + 2 * B_WIDTH)
IN_COLS = 2 * A_WIDTH + 2 * B_KEY + 2 * B_WIDTH + GATE_RANK

kernel_name = "hybrid_gmlp_gla_macaron_encoder"


def rmsnorm(x, w):
    xf = x.astype(jnp.float32)
    y = xf * lax.rsqrt(jnp.mean(xf * xf, axis=-1, keepdims=True) + EPS)
    return (y * w.astype(jnp.float32)).astype(x.dtype)


def swiglu_ffn(h, w_in, w_out):
    a, gate = jnp.split(h @ w_in, 2, axis=-1)
    return (jax.nn.silu(gate) * a) @ w_out


def gmlp_spatial_gating(u, v, w_s, b_s, norm_v):
    bsz, seq, _ = u.shape
    nb = seq // A_BLOCK
    v = rmsnorm(v, norm_v).reshape(bsz, nb, A_BLOCK, A_GROUPS, A_GROUP_DIM)
    chunk_id = jnp.arange(A_BLOCK) // CHUNK
    mask = chunk_id[:, None] >= chunk_id[None, :]
    ws = jnp.where(mask[None], w_s, jnp.zeros_like(w_s))
    z = jnp.einsum('gts,bnsgc->bntgc', ws, v) + b_s.T[None, None, :, :, None].astype(v.dtype)
    return u * z.reshape(bsz, seq, A_WIDTH)


def gated_linear_attention(q, k, v, g, r, w_gk2, b_gk, norm_o):
    out_dtype = v.dtype
    bsz, seq, _ = q.shape
    nc = seq // CHUNK
    f32 = jnp.float32
    qc = q.astype(f32).reshape(bsz, nc, CHUNK, B_HEADS, B_HEAD_K) * (B_HEAD_K ** -0.5)
    kc = k.astype(f32).reshape(bsz, nc, CHUNK, B_HEADS, B_HEAD_K)
    vc = v.astype(f32).reshape(bsz, nc, CHUNK, B_HEADS, B_HEAD_V)
    log_a = jax.nn.log_sigmoid((r @ w_gk2 + b_gk).astype(f32)) / GATE_NORM
    log_a = log_a.reshape(bsz, nc, CHUNK, B_HEADS, B_HEAD_K)
    cum = jnp.cumsum(log_a, axis=2)
    tot = cum[:, :, -1]
    k_dec = kc * jnp.exp(tot[:, :, None] - cum)
    upd = jnp.einsum('bnthk,bnthv->bnhkv', k_dec, vc)
    decay = jnp.exp(tot)

    def step(state, inp):
        d, u = inp
        state = d[..., None] * state + u
        return state, state

    init = jnp.zeros((bsz, B_HEADS, B_HEAD_K, B_HEAD_V), f32)
    _, states = lax.scan(step, init, (jnp.moveaxis(decay, 1, 0), jnp.moveaxis(upd, 1, 0)))
    states = jnp.moveaxis(states, 0, 1)
    o = jnp.einsum('bnthk,bnhkv->bnthv', qc, states)
    o = o * lax.rsqrt(jnp.mean(o * o, axis=-1, keepdims=True) + EPS) * norm_o.astype(f32)
    o = o.reshape(bsz, seq, B_WIDTH).astype(out_dtype)
    return o * jax.nn.silu(g)


def setup_inputs(seed: int = 0) -> dict:
    key = jax.random.key(seed)
    ks = jax.random.split(key, 20)
    f32 = jnp.float32
    nrm = lambda k, shape, scale: jax.random.normal(k, shape, f32) * scale
    gain = lambda k, shape: 1.0 + 0.05 * jax.random.normal(k, shape, f32)
    L = DEPTH
    return {
        "x": nrm(ks[0], (BATCH, SEQ, D_MODEL), 1.0),
        "ff1_norm": gain(ks[1], (L, D_MODEL)),
        "ff1_w_in": nrm(ks[2], (L, D_MODEL, 2 * D_FF), D_MODEL ** -0.5),
        "ff1_w_out": nrm(ks[3], (L, D_FF, D_MODEL), D_FF ** -0.5),
        "mix_norm": gain(ks[4], (L, D_MODEL)),
        "w_in": nrm(ks[5], (L, D_MODEL, IN_COLS), D_MODEL ** -0.5),
        "gmlp_norm_v": gain(ks[6], (L, A_WIDTH)),
        "gmlp_w_s": nrm(ks[7], (L, A_GROUPS, A_BLOCK, A_BLOCK), A_BLOCK ** -0.5),
        "gmlp_b_s": 1.0 + 0.1 * jax.random.normal(ks[8], (L, A_GROUPS, A_BLOCK), f32),
        "gla_w_gk2": nrm(ks[9], (L, GATE_RANK, B_KEY), GATE_RANK ** -0.5),
        "gla_b_gk": nrm(ks[10], (L, B_KEY), 0.1),
        "gla_norm_o": gain(ks[11], (L, B_HEADS, B_HEAD_V)),
        "w_out": nrm(ks[12], (L, D_MIX, D_MODEL), D_MIX ** -0.5),
        "ff2_norm": gain(ks[13], (L, D_MODEL)),
        "ff2_w_in": nrm(ks[14], (L, D_MODEL, 2 * D_FF), D_MODEL ** -0.5),
        "ff2_w_out": nrm(ks[15], (L, D_FF, D_MODEL), D_FF ** -0.5),
        "final_norm": gain(ks[16], (D_MODEL,)),
    }


def reference(x, ff1_norm, ff1_w_in, ff1_w_out, mix_norm, w_in, gmlp_norm_v, gmlp_w_s,
              gmlp_b_s, gla_w_gk2, gla_b_gk, gla_norm_o, w_out, ff2_norm, ff2_w_in,
              ff2_w_out, final_norm):
    for l in range(DEPTH):
        x = x + 0.5 * swiglu_ffn(rmsnorm(x, ff1_norm[l]), ff1_w_in[l], ff1_w_out[l])
        h = rmsnorm(x, mix_norm[l])
        proj = h @ w_in[l]
        u, va, q, k, vb, g, r = jnp.split(proj, SPLITS, axis=-1)
        y_a = gmlp_spatial_gating(u, va, gmlp_w_s[l], gmlp_b_s[l], gmlp_norm_v[l])
        y_b = gated_linear_attention(q, k, vb, g, r, gla_w_gk2[l], gla_b_gk[l], gla_norm_o[l])
        x = x + jnp.concatenate([y_a, y_b], axis=-1) @ w_out[l]
        x = x + 0.5 * swiglu_ffn(rmsnorm(x, ff2_norm[l]), ff2_w_in[l], ff2_w_out[l])
    return rmsnorm(x, final_norm)
```

```cpp
#include <hip/hip_runtime.h>
#include <hip/hip_cooperative_groups.h>
#include <cstdio>
#include <cstdint>
namespace cg = cooperative_groups;
namespace pg8 {
#define PG8_LAS __attribute__((address_space(3)))
typedef unsigned short bf16_t;
typedef short bf16x8 __attribute__((ext_vector_type(8)));
typedef float f32x4 __attribute__((ext_vector_type(4)));
typedef unsigned u32x4 __attribute__((ext_vector_type(4)));
constexpr int BM = 256, BK = 64, HALF = 128, HTB = HALF * BK * 2  , STAGE_BYTES = 8 * HTB, NXCD = 8, WGM = 4;

__host__ __device__ __forceinline__ int lds_byte(int r, int c) { const int st = (r >> 4) * 2 + (c >> 5), rr = r & 15, cc = c & 31, ob = rr * 64 + cc * 2; return st * 1024 + (ob ^ (((ob >> 9) & 1) << 5)); }
__host__ __device__ __forceinline__ void stage_rc(int b, int& R, int& C) { const int st = b / 1024, sb = b % 1024, swz = sb ^ (((sb >> 9) & 1) << 5); R = (st >> 1) * 16 + swz / 64; C = (st & 1) * 32 + (swz % 64) / 2; }
__host__ __device__ __forceinline__ int perm32(int rho) { const int n = rho >> 4, i = rho & 15; return 8 * (i >> 2) + 4 * n + (i & 3); }

struct Unit { int pm, pn; };
struct Gemm { const bf16_t* A; const bf16_t* Bt; int M, N, K; };

struct StaticOrder {
    int nM, nN, nwg, G, c;
    __host__ __device__ void init(int M, int N, int G_, int c_) { nM = M / BM; nN = N / BM; nwg = nM * nN; G = G_; c = c_; }
    __host__ __device__ bool next(int i, Unit& u) const {
        const long L = (long)i * G + c; if (L >= nwg) return false;
        int wgid = (int)L; { const int q = nwg / NXCD, r = nwg % NXCD, xcd = wgid % NXCD, off = wgid / NXCD; wgid = (xcd < r ? xcd * (q + 1) : r * (q + 1) + (xcd - r) * q) + off; }
        const int nig = WGM * nN, gid = wgid / nig, fm = gid * WGM, gsz = (nM - fm) < WGM ? (nM - fm) : WGM;
        u.pm = fm + ((wgid % nig) % gsz); u.pn = (wgid % nig) / gsz; return true;
    }
    __device__ __forceinline__ void a_ready(const Unit&) const {}
    __device__ __forceinline__ void done(const Unit&) const {}
};

struct GroupOrder {
    int nM, nN, nwg, G, c;
    __host__ __device__ void init(int M, int N, int G_, int c_) { nM = M / BM; nN = N / BM; nwg = nM * nN; G = G_; c = c_; }
    __host__ __device__ bool next(int i, Unit& u) const {
        const int L = i * G + c; if (L >= nwg) return false;
        const int nig = WGM * nN, gid = L / nig, fm = gid * WGM, gsz = (nM - fm) < WGM ? (nM - fm) : WGM;
        u.pm = fm + ((L % nig) % gsz); u.pn = (L % nig) / gsz; return true;
    }
    __device__ __forceinline__ void a_ready(const Unit&) const {}
    __device__ __forceinline__ void done(const Unit&) const {}
};

__device__ __forceinline__ unsigned cvt_pk_bf16(float lo, float hi) { unsigned r; asm volatile("v_cvt_pk_bf16_f32 %0, %1, %2" : "=v"(r) : "v"(lo), "v"(hi)); return r; }
typedef unsigned u32x2 __attribute__((ext_vector_type(2)));
typedef unsigned long long u64;
typedef float f32x2v __attribute__((ext_vector_type(2)));
__device__ __forceinline__ u64 ss_fix(float s) { return (u64)(s * 1099511627776.0f); }
__device__ __forceinline__ float ss_val(u64 v) { return (float)v * (1.0f / 1099511627776.0f); }
__device__ __forceinline__ float fast_silu(float g) { return g * __builtin_amdgcn_rcpf(1.0f + __expf(-g)); }
struct EpiSwiglu {
    static constexpr bool PERM = true, AFTER_DRAIN = false;
    bf16_t* O; int ldc; const u64* rowss; float inv_k, eps;
    __device__ __forceinline__ void operator()(const f32x4 (&acc)[2][2][4][2], const Unit& u, const Unit& nxt, bool has_next, int wr, int wc, int fr, int fq) const {
        const int row0 = u.pm * BM + wr * 64 + fr, col0 = u.pn * HALF + wc * 32 + 8 * fq;
        u64 cur[8], warm[8];
#pragma unroll
        for (int g = 0; g < 8; ++g) cur[g] = rowss[row0 + (g >> 2) * HALF + (g & 3) * 16];
        if (has_next) {
#pragma unroll
            for (int g = 0; g < 8; ++g) warm[g] = rowss[nxt.pm * BM + wr * 64 + fr + (g >> 2) * HALF + (g & 3) * 16];
        }
#pragma unroll
        for (int g = 0; g < 8; ++g) {
            const int ai = g >> 2, m = g & 3;
            const float rs = __builtin_amdgcn_rsqf(ss_val(cur[g]) * inv_k + eps), rsn = rs * -1.44269504089f, rs2 = rs * rs;
            float h[8];
#pragma unroll
            for (int n = 0; n < 2; ++n)
#pragma unroll
                for (int jp = 0; jp < 2; ++jp) {
                    const f32x2v av = {acc[ai][0][m][n][2 * jp], acc[ai][0][m][n][2 * jp + 1]}, gv = {acc[ai][1][m][n][2 * jp], acc[ai][1][m][n][2 * jp + 1]};
                    const f32x2v t = (av * gv) * rs2, y = gv * rsn;
                    f32x2v ex; ex.x = __builtin_amdgcn_exp2f(y.x); ex.y = __builtin_amdgcn_exp2f(y.y);
                    const f32x2v d = ex + 1.0f;
                    f32x2v r; r.x = __builtin_amdgcn_rcpf(d.x); r.y = __builtin_amdgcn_rcpf(d.y);
                    const f32x2v o = t * r;
                    h[4 * n + 2 * jp] = o.x; h[4 * n + 2 * jp + 1] = o.y;
                }
            u32x4 w; w.x = cvt_pk_bf16(h[0], h[1]); w.y = cvt_pk_bf16(h[2], h[3]); w.z = cvt_pk_bf16(h[4], h[5]); w.w = cvt_pk_bf16(h[6], h[7]);
            *(u32x4*)(O + (size_t)(row0 + ai * HALF + m * 16) * ldc + col0) = w;
        }
        if (has_next) { u64 x = 0;
#pragma unroll
            for (int g = 0; g < 8; ++g) x |= warm[g];
            asm volatile("" :: "v"((unsigned)x), "v"((unsigned)(x >> 32))); }
    }
};
struct EpiResid {
    static constexpr bool PERM = true, AFTER_DRAIN = false;
    const float* base32; bf16_t* xs; u64* rowss; float alpha; int ldc;
    __device__ __forceinline__ void operator()(const f32x4 (&acc)[2][2][4][2], const Unit& u, const Unit&, bool, int wr, int wc, int fr, int fq) const {
        const int row0 = u.pm * BM + wr * 64 + fr, col0 = u.pn * BM + wc * 32 + 8 * fq;
        bf16_t* xp = xs + (size_t)row0 * ldc + col0;
        float ss[8];
        u32x4 pre[3][2];
        if (!base32) {
#pragma unroll
            for (int q = 0; q < 2; ++q)
#pragma unroll
                for (int bj = 0; bj < 2; ++bj) pre[q][bj] = *(const u32x4*)(xp + (size_t)((q >> 2) * HALF + (q & 3) * 16) * ldc + bj * HALF);
        }
#pragma unroll
        for (int g = 0; g < 8; ++g) {
            const int ai = g >> 2, m = g & 3; const size_t roff = (size_t)(ai * HALF + m * 16) * ldc; float s = 0.f;
            if (!base32 && g + 2 < 8) {
#pragma unroll
                for (int bj = 0; bj < 2; ++bj) pre[(g + 2) % 3][bj] = *(const u32x4*)(xp + (size_t)(((g + 2) >> 2) * HALF + ((g + 2) & 3) * 16) * ldc + bj * HALF);
            }
            asm volatile("" ::: "memory");
#pragma unroll
            for (int bj = 0; bj < 2; ++bj) {
                float b[8];
                if (base32) {
                    const f32x4 b0 = *(const f32x4*)(base32 + (size_t)row0 * ldc + col0 + roff + bj * HALF), b1 = *(const f32x4*)(base32 + (size_t)row0 * ldc + col0 + roff + bj * HALF + 4);
                    b[0] = b0[0]; b[1] = b0[1]; b[2] = b0[2]; b[3] = b0[3]; b[4] = b1[0]; b[5] = b1[1]; b[6] = b1[2]; b[7] = b1[3];
                } else {
                    const u32x4 bw = pre[g % 3][bj];
#pragma unroll
                    for (int e = 0; e < 4; ++e) { b[2 * e] = __builtin_bit_cast(float, bw[e] << 16); b[2 * e + 1] = __builtin_bit_cast(float, bw[e] & 0xffff0000u); }
                }
                u32x4 w;
#pragma unroll
                for (int e = 0; e < 4; ++e) {
                    const float o0 = b[2 * e] + acc[ai][bj][m][e >> 1][(2 * e) & 3] * alpha, o1 = b[2 * e + 1] + acc[ai][bj][m][e >> 1][(2 * e + 1) & 3] * alpha;
                    const unsigned pw = cvt_pk_bf16(o0, o1); w[e] = pw;
                    const float r0 = __builtin_bit_cast(float, pw << 16), r1 = __builtin_bit_cast(float, pw & 0xffff0000u);
                    s += r0 * r0 + r1 * r1;
                }
                *(u32x4*)(xp + roff + bj * HALF) = w;
            }
            ss[g] = s;
            asm volatile("" ::: "memory");
        }
#pragma unroll
        for (int g = 0; g < 8; ++g) {
            float s = ss[g]; s += __shfl_xor(s, 16); s += __shfl_xor(s, 32);
            if (fq == 0) atomicAdd(rowss + row0 + (g >> 2) * HALF + (g & 3) * 16, ss_fix(s));
        }
    }
};
struct EpiProj {
    static constexpr bool PERM = true, AFTER_DRAIN = false;
    bf16_t* O; int ldc; const u64* rowss; u64* rowss_v; float* R; float inv_k, eps;
    __device__ __forceinline__ void operator()(const f32x4 (&acc)[2][2][4][2], const Unit& u, const Unit&, bool, int wr, int wc, int fr, int fq) const {
        const int row0 = u.pm * BM + wr * 64 + fr;
        const bool is_va = (u.pn == 2) || (u.pn == 3);
        const int col0 = u.pn * BM + wc * 32 + 8 * fq;
        u64 cur[8];
#pragma unroll
        for (int g = 0; g < 8; ++g) cur[g] = rowss[row0 + (g >> 2) * HALF + (g & 3) * 16];
        asm volatile("" : "+v"(cur[0]), "+v"(cur[1]), "+v"(cur[2]), "+v"(cur[3]), "+v"(cur[4]), "+v"(cur[5]), "+v"(cur[6]), "+v"(cur[7]) :: "memory");
#pragma unroll
        for (int ai = 0; ai < 2; ++ai)
#pragma unroll
            for (int m = 0; m < 4; ++m) {
                const int row = row0 + ai * HALF + m * 16;
                const float rs = __builtin_amdgcn_rsqf(ss_val(cur[ai * 4 + m]) * inv_k + eps);
                float ss = 0.f;
#pragma unroll
                for (int bj = 0; bj < 2; ++bj) {
                    const f32x4 v0 = acc[ai][bj][m][0] * rs, v1 = acc[ai][bj][m][1] * rs;
                    ss += (v0[0] * v0[0] + v0[1] * v0[1]) + (v0[2] * v0[2] + v0[3] * v0[3]) + (v1[0] * v1[0] + v1[1] * v1[1]) + (v1[2] * v1[2] + v1[3] * v1[3]);
                    u32x4 w; w.x = cvt_pk_bf16(v0[0], v0[1]); w.y = cvt_pk_bf16(v0[2], v0[3]); w.z = cvt_pk_bf16(v1[0], v1[1]); w.w = cvt_pk_bf16(v1[2], v1[3]);
                    *(u32x4*)(O + (size_t)row * ldc + col0 + bj * HALF) = w;
                }
                if (is_va) { ss += __shfl_xor(ss, 16); ss += __shfl_xor(ss, 32); if (fq == 0) atomicAdd(rowss_v + row, ss_fix(ss)); }
            }
    }
};
template <class Epi, class Sched, bool ALIGN_EPI = false, bool SP2 = false>
__device__ __forceinline__ void gemm_phase(PG8_LAS unsigned char* lds, const Gemm g, const Sched& S, const Epi& E) {
    const int tid = threadIdx.x, wid = __builtin_amdgcn_readfirstlane(tid >> 6), lane = tid & 63, wr = wid >> 2, wc = wid & 3, fr = lane & 15, fq = lane >> 4;
    const int K = g.K, nt = K / BK;
    unsigned voffA[2], voffB[2];
#pragma unroll
    for (int i = 0; i < 2; ++i) { int R, C; stage_rc(tid * 16 + i * 8192, R, C); const int Rb = Epi::PERM ? ((R & ~31) + perm32(R & 31)) : R;
        voffA[i] = (unsigned)(R * K + C) * 2u; voffB[i] = (unsigned)(Rb * K + C) * 2u; }
    const size_t kstep = (size_t)(BK * 2);
    const size_t hstep = (size_t)HALF * K * 2;
    const size_t tstep = 2 * hstep;
    const unsigned ldsw = (unsigned)wid * 1024u;
    const int aoff = lds_byte(wr * 64 + fr, fq * 8), boff = lds_byte(wc * 32 + fr, fq * 8);
#define PG8_SA(b, h) (((b) * 2 + (h)) * HTB)
#define PG8_SB(b, h) ((4 + (b) * 2 + (h)) * HTB)
#define PG8_STAGE(bufoff, gbase, voff) do { _Pragma("unroll") for (int _i = 0; _i < 2; ++_i) \
        __builtin_amdgcn_global_load_lds((const unsigned*)((const char*)(gbase) + (voff)[_i]), (PG8_LAS unsigned*)(lds + (bufoff) + ldsw + _i * 8192), 16, 0, 0); } while (0)
#define PG8_LDA(dst, b, h) do { _Pragma("unroll") for (int m = 0; m < 4; ++m) _Pragma("unroll") for (int k = 0; k < 2; ++k) dst[m][k] = *(const PG8_LAS bf16x8*)(lds + PG8_SA(b, h) + aoff + m * 2048 + k * 1024); } while (0)
#define PG8_LDB(dst, b, h) do { _Pragma("unroll") for (int n = 0; n < 2; ++n) _Pragma("unroll") for (int k = 0; k < 2; ++k) dst[n][k] = *(const PG8_LAS bf16x8*)(lds + PG8_SB(b, h) + boff + n * 2048 + k * 1024); } while (0)
#define PG8_MMA(ai, bj, At, Bt) do { __builtin_amdgcn_s_setprio(1); _Pragma("unroll") for (int m = 0; m < 4; ++m) _Pragma("unroll") for (int n = 0; n < 2; ++n) _Pragma("unroll") for (int k = 0; k < 2; ++k) \
        acc[ai][bj][m][n] = __builtin_amdgcn_mfma_f32_16x16x32_bf16(Bt[n][k], At[m][k], acc[ai][bj][m][n], 0, 0, 0); __builtin_amdgcn_s_setprio(0); } while (0)
#define PG8_WAIT_V(n) asm volatile("s_waitcnt vmcnt(" #n ")" ::: "memory")
#define PG8_WAIT_L(n) asm volatile("s_waitcnt lgkmcnt(" #n ")" ::: "memory")
#define PG8_BAR __builtin_amdgcn_s_barrier()
#define PG8_SCHED __builtin_amdgcn_sched_barrier(0)
    Unit cur, nxt; int ui = 0;
    if (!S.next(0, cur)) return;
    f32x4 acc[2][2][4][2];
#pragma unroll
    for (int a = 0; a < 2; ++a)
#pragma unroll
        for (int b = 0; b < 2; ++b)
#pragma unroll
            for (int m = 0; m < 4; ++m)
#pragma unroll
                for (int n = 0; n < 2; ++n) acc[a][b][m][n] = (f32x4){0.f, 0.f, 0.f, 0.f};
    bf16x8 At[4][2], B0[2][2], B1[2][2];
    const char* cA = (const char*)g.A + (size_t)cur.pm * tstep; const char* cB = (const char*)g.Bt + (size_t)cur.pn * tstep;
    S.a_ready(cur);
    if constexpr (SP2) {
        PG8_STAGE(PG8_SB(0, 0), cB, voffB); PG8_STAGE(PG8_SB(0, 1), cB + hstep, voffB); PG8_STAGE(PG8_SA(0, 0), cA, voffA); PG8_STAGE(PG8_SA(0, 1), cA + hstep, voffA);
        if (wr == 1) PG8_BAR;
        PG8_WAIT_V(2); PG8_BAR;
        PG8_STAGE(PG8_SB(1, 0), cB + kstep, voffB); PG8_STAGE(PG8_SA(1, 0), cA + kstep, voffA); PG8_STAGE(PG8_SB(1, 1), cB + hstep + kstep, voffB);
        PG8_WAIT_V(6); PG8_BAR;
    } else {
        PG8_STAGE(PG8_SB(0, 0), cB, voffB); PG8_STAGE(PG8_SA(0, 0), cA, voffA); PG8_STAGE(PG8_SB(0, 1), cB + hstep, voffB); PG8_STAGE(PG8_SA(0, 1), cA + hstep, voffA);
        if (wr == 1) PG8_BAR;
        PG8_WAIT_V(4); PG8_BAR;
        PG8_STAGE(PG8_SB(1, 0), cB + kstep, voffB); PG8_STAGE(PG8_SA(1, 0), cA + kstep, voffA); PG8_STAGE(PG8_SB(1, 1), cB + hstep + kstep, voffB);
        PG8_WAIT_V(6); PG8_BAR;
    }
    for (;;) {
        const bool has_next = S.next(ui + 1, nxt);
        const char* nA = has_next ? (const char*)g.A + (size_t)nxt.pm * tstep : cA; const char* nB = has_next ? (const char*)g.Bt + (size_t)nxt.pn * tstep : cB;
        for (int t = 0; t < nt; t += 2) {
            const bool last = (t == nt - 2);
            const char* a1 = cA + (size_t)(t + 1) * kstep;
            const char* a2 = last ? nA : cA + (size_t)(t + 2) * kstep; const char* b2 = last ? nB : cB + (size_t)(t + 2) * kstep;
            const char* a3 = a2 + kstep; const char* b3 = b2 + kstep;
            if (last && has_next) S.a_ready(nxt);
            if constexpr (SP2) {
            PG8_LDB(B0, 0, 0); PG8_LDB(B1, 0, 1); PG8_SCHED; PG8_LDA(At, 0, 0); PG8_STAGE(PG8_SA(1, 1), a1 + hstep, voffA);
            PG8_WAIT_V(8); PG8_WAIT_L(0); PG8_BAR; PG8_MMA(0, 0, At, B0); PG8_MMA(0, 1, At, B1); PG8_BAR; PG8_SCHED;
            PG8_LDA(At, 0, 1); PG8_STAGE(PG8_SB(0, 0), b2, voffB); PG8_STAGE(PG8_SB(0, 1), b2 + hstep, voffB); PG8_STAGE(PG8_SA(0, 0), a2, voffA);
            PG8_WAIT_V(8); PG8_WAIT_L(0); PG8_BAR; PG8_MMA(1, 0, At, B0); PG8_MMA(1, 1, At, B1); PG8_BAR; PG8_SCHED;
            PG8_LDB(B0, 1, 0); PG8_LDB(B1, 1, 1); PG8_SCHED; PG8_LDA(At, 1, 0); PG8_STAGE(PG8_SA(0, 1), a2 + hstep, voffA);
            PG8_WAIT_V(8); PG8_WAIT_L(0); PG8_BAR; PG8_MMA(0, 0, At, B0); PG8_MMA(0, 1, At, B1); PG8_BAR; PG8_SCHED;
            PG8_LDA(At, 1, 1); PG8_STAGE(PG8_SB(1, 0), b3, voffB); PG8_STAGE(PG8_SB(1, 1), b3 + hstep, voffB); PG8_STAGE(PG8_SA(1, 0), a3, voffA);
            PG8_WAIT_V(8); PG8_WAIT_L(0); PG8_BAR; PG8_MMA(1, 0, At, B0); PG8_MMA(1, 1, At, B1); PG8_BAR; PG8_SCHED;
            } else {
            PG8_LDB(B0, 0, 0); PG8_SCHED; PG8_LDA(At, 0, 0); PG8_STAGE(PG8_SA(1, 1), a1 + hstep, voffA);
            PG8_WAIT_L(8); PG8_BAR; PG8_WAIT_L(0); PG8_MMA(0, 0, At, B0); PG8_BAR; PG8_SCHED;
            PG8_LDB(B1, 0, 1); PG8_STAGE(PG8_SB(0, 0), b2, voffB);
            PG8_BAR; PG8_WAIT_L(0); PG8_MMA(0, 1, At, B1); PG8_BAR;
            PG8_LDA(At, 0, 1); PG8_STAGE(PG8_SA(0, 0), a2, voffA);
            PG8_BAR; PG8_WAIT_L(0); PG8_MMA(1, 0, At, B0); PG8_BAR; PG8_SCHED;
            PG8_STAGE(PG8_SB(0, 1), b2 + hstep, voffB);
            PG8_WAIT_V(6); PG8_BAR; PG8_MMA(1, 1, At, B1); PG8_BAR;
            PG8_LDB(B0, 1, 0); PG8_SCHED; PG8_LDA(At, 1, 0); PG8_STAGE(PG8_SA(0, 1), a2 + hstep, voffA);
            PG8_WAIT_L(8); PG8_BAR; PG8_WAIT_L(0); PG8_MMA(0, 0, At, B0); PG8_BAR; PG8_SCHED;
            PG8_LDB(B1, 1, 1); PG8_STAGE(PG8_SB(1, 0), b3, voffB);
            PG8_BAR; PG8_WAIT_L(0); PG8_MMA(0, 1, At, B1); PG8_BAR;
            PG8_LDA(At, 1, 1); PG8_STAGE(PG8_SA(1, 0), a3, voffA);
            PG8_BAR; PG8_WAIT_L(0); PG8_MMA(1, 0, At, B0); PG8_BAR; PG8_SCHED;
            PG8_STAGE(PG8_SB(1, 1), b3 + hstep, voffB);
            PG8_WAIT_V(6); PG8_BAR; PG8_MMA(1, 1, At, B1); PG8_BAR;
            }
        }
        if constexpr (ALIGN_EPI) { if (wr == 0) PG8_BAR; }
        if constexpr (!Epi::AFTER_DRAIN) { E(acc, cur, nxt, has_next, wr, wc, fr, fq); S.done(cur); }
        if (!has_next) break;
#pragma unroll
        for (int a = 0; a < 2; ++a)
#pragma unroll
            for (int b = 0; b < 2; ++b)
#pragma unroll
                for (int m = 0; m < 4; ++m)
#pragma unroll
                    for (int n = 0; n < 2; ++n) acc[a][b][m][n] = (f32x4){0.f, 0.f, 0.f, 0.f};
        cur = nxt; cA = nA; cB = nB; ++ui;
        if constexpr (ALIGN_EPI) { if (wr == 1) PG8_BAR; }
    }
    PG8_WAIT_V(0);
    if constexpr (!ALIGN_EPI) { if (wr == 0) PG8_BAR; }
    PG8_BAR;
    if constexpr (Epi::AFTER_DRAIN) { E.fused(acc, cur, wr, wc, fr, fq, lds, wid, lane); S.done(cur); }
#undef PG8_SA
#undef PG8_SB
#undef PG8_STAGE
#undef PG8_LDA
#undef PG8_LDB
#undef PG8_MMA
#undef PG8_WAIT_V
#undef PG8_WAIT_L
#undef PG8_BAR
#undef PG8_SCHED
}
}
#define LAS __attribute__((address_space(3)))
typedef unsigned short bf16;
typedef float f32x4 __attribute__((ext_vector_type(4)));
typedef float f32x2 __attribute__((ext_vector_type(2)));
typedef unsigned u32x4 __attribute__((ext_vector_type(4)));
typedef unsigned u32x2 __attribute__((ext_vector_type(2)));
typedef short bf16x8 __attribute__((ext_vector_type(8)));
typedef unsigned long long u64;
using pg8::ss_fix; using pg8::ss_val;
#define LDS_WAIT() asm volatile("s_waitcnt lgkmcnt(0)" ::: "memory")

constexpr int NBATCH = 8, SEQ = 4096, D = 1024, M = NBATCH * SEQ, DFF = 2816, NFF = 2 * DFF, NPROJ = 2816, INCOLS = 2576, DEPTH = 2;
constexpr float EPS = 1e-6f;
constexpr int NTHREADS = 512, NWAVES = 8;
constexpr int LDS_BYTES = 147456 + 256, WAVE_LDS = 18432, MISC_OFF = 147456;
constexpr int NPHASE = 20, NGRP = NBATCH;
#ifndef MK_MULTI
#define MK_MULTI 0
#endif

constexpr size_t MiB = 1u << 20;
constexpr size_t WS_ROWSS = 1 * MiB;
constexpr size_t WS_DEC = 4 * MiB;
constexpr size_t WS_R = 5 * MiB;
constexpr size_t WS_WSB = 7 * MiB;
constexpr size_t WS_W = 8 * MiB;
constexpr size_t W_L = 40 * MiB + MiB / 2;
constexpr size_t W1_OFF = 0, W2_OFF = 11 * MiB, WIN_OFF = 16 * MiB + MiB / 2, WOUT_OFF = 22 * MiB, W3_OFF = 24 * MiB, W4_OFF = 35 * MiB;
constexpr size_t WS_XN = 96 * MiB;
constexpr size_t WS_H = 160 * MiB;
constexpr size_t WS_Y = 336 * MiB;
constexpr size_t WS_UPD = 400 * MiB;
constexpr size_t WS_ST = 464 * MiB;
constexpr size_t WS_END = 496 * MiB;

__device__ __forceinline__ unsigned f2bf(float f) { unsigned u = __builtin_bit_cast(unsigned, f); return (u + 0x7fffu + ((u >> 16) & 1u)) >> 16; }
__device__ __forceinline__ unsigned pk2(float lo, float hi) { return f2bf(lo) | (f2bf(hi) << 16); }
__device__ __forceinline__ float bf_lo(unsigned w) { return __builtin_bit_cast(float, w << 16); }
__device__ __forceinline__ float bf_hi(unsigned w) { return __builtin_bit_cast(float, w & 0xffff0000u); }
__device__ __forceinline__ float bf2f(bf16 h) { return __builtin_bit_cast(float, (unsigned)h << 16); }
__device__ __forceinline__ float wave_sum(float v) {
#pragma unroll
    for (int o = 1; o < 64; o <<= 1) v += __shfl_xor(v, o);
    return v;
}
__device__ __forceinline__ float silu_f(float g) { return g * __builtin_amdgcn_rcpf(1.0f + __expf(-g)); }

__device__ __forceinline__ void tr_item(const float* W, int K, int N, const float* kscale, bf16* WT, int dst_row0, LAS float* scr, int k0, int n0, int lane) {
    const int n4 = 4 * (lane & 7); const bool ok = (n0 + n4) < N;
#pragma unroll
    for (int i = 0; i < 8; ++i) { const int kk = 8 * i + (lane >> 3); f32x4 v = ok ? *(const f32x4*)(W + (size_t)(k0 + kk) * N + n0 + n4) : (f32x4){0.f, 0.f, 0.f, 0.f}; if (kscale) v = v * kscale[k0 + kk];
        scr[kk * 33 + n4] = v[0]; scr[kk * 33 + n4 + 1] = v[1]; scr[kk * 33 + n4 + 2] = v[2]; scr[kk * 33 + n4 + 3] = v[3]; }
    LDS_WAIT(); asm volatile("" ::: "memory");
    const int c = lane & 7;
#pragma unroll
    for (int j = 0; j < 4; ++j) { const int n = (lane >> 3) + 8 * j; const LAS float* s = scr + (8 * c) * 33 + n;
        u32x4 o; o.x = pk2(s[0 * 33], s[1 * 33]); o.y = pk2(s[2 * 33], s[3 * 33]); o.z = pk2(s[4 * 33], s[5 * 33]); o.w = pk2(s[6 * 33], s[7 * 33]);
        *(u32x4*)(WT + (size_t)(dst_row0 + n) * K + k0 + 8 * c) = o; }
    LDS_WAIT(); asm volatile("" ::: "memory");
}

struct Args { const float* in[17]; float* out; unsigned char* ws; int ph_lo, ph_hi; };

__device__ __forceinline__ void prologue(const Args& a, LAS unsigned char* lds, int wave, int lane) {
    unsigned char* ws = a.ws;
    LAS float* scr = (LAS float*)(lds + wave * 16384);
    const int gw = blockIdx.x * NWAVES + wave, NGW = gridDim.x * NWAVES;
    constexpr int I_W1 = (D / 64) * (NFF / 32), I_W2 = (DFF / 64) * (D / 32), I_WIN = (D / 64) * (NPROJ / 32), I_WOUT = (D / 64) * (D / 32);
    constexpr int I_L = 2 * I_W1 + 2 * I_W2 + I_WIN + I_WOUT;
    for (int it = gw; it < DEPTH * I_L; it += NGW) {
        const int l = it / I_L; int r = it % I_L;
        unsigned char* wl = ws + WS_W + (size_t)l * W_L;
        if (r < 2 * I_W1) {
            const bool second = r >= I_W1; if (second) r -= I_W1;
            const float* W = a.in[second ? 14 : 2] + (size_t)l * D * NFF; const float* ks = a.in[second ? 13 : 1] + (size_t)l * D;
            const int nblk = NFF / 32, kb = r / nblk, nb = r % nblk, n0 = 32 * nb;
            const int dst = n0 < DFF ? (n0 / 128) * 256 + (n0 % 128) : ((n0 - DFF) / 128) * 256 + 128 + ((n0 - DFF) % 128);
            tr_item(W, D, NFF, ks, (bf16*)(wl + (second ? W3_OFF : W1_OFF)), dst, scr, 64 * kb, n0, lane);
            continue;
        }
        r -= 2 * I_W1;
        if (r < 2 * I_W2) {
            const bool second = r >= I_W2; if (second) r -= I_W2;
            const float* W = a.in[second ? 15 : 3] + (size_t)l * DFF * D;
            const int nblk = D / 32, kb = r / nblk, nb = r % nblk;
            tr_item(W, DFF, D, nullptr, (bf16*)(wl + (second ? W4_OFF : W2_OFF)), 32 * nb, scr, 64 * kb, 32 * nb, lane);
            continue;
        }
        r -= 2 * I_W2;
        if (r < I_WIN) {
            const float* W = a.in[5] + (size_t)l * D * INCOLS; const float* ks = a.in[4] + (size_t)l * D;
            const int nblk = NPROJ / 32, kb = r / nblk, nb = r % nblk;
            tr_item(W, D, INCOLS, ks, (bf16*)(wl + WIN_OFF), 32 * nb, scr, 64 * kb, 32 * nb, lane);
            continue;
        }
        r -= I_WIN;
        {
            const float* W = a.in[12] + (size_t)l * D * D;
            const int nblk = D / 32, kb = r / nblk, nb = r % nblk;
            tr_item(W, D, D, nullptr, (bf16*)(wl + WOUT_OFF), 32 * nb, scr, 64 * kb, 32 * nb, lane);
        }
    }
    const int gt = blockIdx.x * NTHREADS + threadIdx.x, NGT = gridDim.x * NTHREADS;
    { const float* wsrc = a.in[7]; bf16* wsb = (bf16*)(ws + WS_WSB);
      for (int e = gt; e < DEPTH * 8 * 128 * 128; e += NGT) { const int s = e & 127, t = (e >> 7) & 127; const float v = ((t >> 6) >= (s >> 6)) ? wsrc[e] : 0.f; wsb[e] = (bf16)f2bf(v); } }
    { u64* rs = (u64*)(ws + WS_ROWSS) + M; for (int e = gt; e < 8 * M; e += NGT) rs[e] = 0ull; }
    { const float* x = a.in[0]; bf16* XN = (bf16*)(ws + WS_XN); u64* rs0 = (u64*)(ws + WS_ROWSS);
      for (int m = 2 * gw; m < M; m += 2 * NGW) {
          const f32x4* xr = (const f32x4*)(x + (size_t)m * D) + lane; f32x4 v[2][4]; float s[2] = {0.f, 0.f};
#pragma unroll
          for (int r = 0; r < 2; ++r)
#pragma unroll
              for (int j = 0; j < 4; ++j) v[r][j] = xr[r * (D / 4) + 64 * j];
#pragma unroll
          for (int r = 0; r < 2; ++r) {
#pragma unroll
              for (int j = 0; j < 4; ++j) s[r] += (v[r][j][0] * v[r][j][0] + v[r][j][1] * v[r][j][1]) + (v[r][j][2] * v[r][j][2] + v[r][j][3] * v[r][j][3]);
              s[r] = wave_sum(s[r]); if (lane == 0) rs0[m + r] = ss_fix(s[r]);
              u32x2* o = (u32x2*)(XN + (size_t)(m + r) * D) + lane;
#pragma unroll
              for (int j = 0; j < 4; ++j) { u32x2 w; w.x = pk2(v[r][j][0], v[r][j][1]); w.y = pk2(v[r][j][2], v[r][j][3]); o[64 * j] = w; }
          }
      } }
}

__device__ __forceinline__ void rank_unit(const bf16* XN, const bf16* WrT, const u64* rowss, float* R, int m0, int lane) {
    const int fr = lane & 15, fq = lane >> 4;
    const bf16* ap = XN + (size_t)(m0 + fr) * D + 8 * fq; const bf16* bp = WrT + (size_t)fr * D + 8 * fq;
    f32x4 acc0 = (f32x4){0.f, 0.f, 0.f, 0.f}, acc1 = (f32x4){0.f, 0.f, 0.f, 0.f};
#pragma unroll 8
    for (int ki = 0; ki < 32; ki += 2) {
        const bf16x8 a0 = *(const bf16x8*)(ap + 32 * ki), b0 = *(const bf16x8*)(bp + 32 * ki), a1 = *(const bf16x8*)(ap + 32 * ki + 32), b1 = *(const bf16x8*)(bp + 32 * ki + 32);
        acc0 = __builtin_amdgcn_mfma_f32_16x16x32_bf16(b0, a0, acc0, 0, 0, 0);
        acc1 = __builtin_amdgcn_mfma_f32_16x16x32_bf16(b1, a1, acc1, 0, 0, 0);
    }
    { const int row = m0 + fr; const float rs = __builtin_amdgcn_rsqf(ss_val(rowss[row]) * (1.f / D) + EPS); *(f32x4*)(R + (size_t)row * 16 + 4 * fq) = (acc0 + acc1) * rs; }
}

template <int HF>
__device__ __forceinline__ void gmlp_half(LAS unsigned char* wl, const bf16* PROJ, const bf16* wsg, const float* norm_v, const float* b_s, bf16* Y, int tok0, int g, int fr, int fq) {
    constexpr int VS = 136, NK = HF ? 4 : 2;
    bf16x8 bw[NK][4];
#pragma unroll
    for (int ki = 0; ki < NK; ++ki)
#pragma unroll
        for (int nt = 0; nt < 4; ++nt) bw[ki][nt] = *(const bf16x8*)(wsg + (size_t)(64 * HF + 16 * nt + fr) * 128 + 32 * ki + 8 * fq);
    f32x4 acc[4][4];
#pragma unroll
    for (int i = 0; i < 4; ++i)
#pragma unroll
        for (int j = 0; j < 4; ++j) acc[i][j] = (f32x4){0.f, 0.f, 0.f, 0.f};
#pragma unroll
    for (int ki = 0; ki < NK; ++ki) {
        bf16x8 av[4];
#pragma unroll
        for (int mi = 0; mi < 4; ++mi) av[mi] = *(const LAS bf16x8*)(wl + ((32 * (mi >> 1) + 8 * (fr >> 2) + 4 * (mi & 1) + (fr & 3)) * VS + 32 * ki + 8 * fq) * 2);
#pragma unroll
        for (int nt = 0; nt < 4; ++nt)
#pragma unroll
            for (int mi = 0; mi < 4; ++mi) acc[mi][nt] = __builtin_amdgcn_mfma_f32_16x16x32_bf16(av[mi], bw[ki][nt], acc[mi][nt], 0, 0, 0);
    }
    asm volatile("" ::: "memory");
    f32x4 nv[2][2];
#pragma unroll
    for (int p = 0; p < 2; ++p) { nv[p][0] = *(const f32x4*)(norm_v + g * 64 + 32 * p + 8 * fq); nv[p][1] = *(const f32x4*)(norm_v + g * 64 + 32 * p + 8 * fq + 4); }
#pragma unroll
    for (int nt = 0; nt < 4; ++nt) {
        const int t = 64 * HF + 16 * nt + fr; const size_t tok = (size_t)(tok0 + t); const float bs = b_s[g * 128 + t];
        u32x4 uu[2];
#pragma unroll
        for (int p = 0; p < 2; ++p) uu[p] = *(const u32x4*)(PROJ + tok * NPROJ + g * 64 + 32 * p + 8 * fq);
#pragma unroll
        for (int p = 0; p < 2; ++p) {
            u32x4 w;
#pragma unroll
            for (int e2 = 0; e2 < 2; ++e2) {
                const f32x4 z = nv[p][e2] * acc[2 * p + e2][nt] + bs;
                const unsigned u0 = uu[p][2 * e2], u1 = uu[p][2 * e2 + 1];
                w[2 * e2] = pk2(bf_lo(u0) * z[0], bf_hi(u0) * z[1]); w[2 * e2 + 1] = pk2(bf_lo(u1) * z[2], bf_hi(u1) * z[3]);
            }
            *(u32x4*)(Y + tok * D + g * 64 + 32 * p + 8 * fq) = w;
        }
    }
}
__device__ __forceinline__ void gmlp_unit(LAS unsigned char* wl, const bf16* PROJ, const u64* rowss_v, const bf16* wsb, const float* norm_v, const float* b_s, bf16* Y, int nb, int g, int lane) {
    constexpr int VS = 136;
    LAS unsigned* VT32 = (LAS unsigned*)wl;
    const int tok0 = nb * 128, sp = lane >> 3, cc = lane & 7;
#pragma unroll 4
    for (int it = 0; it < 8; ++it) {
        const int s0 = it * 16 + 2 * sp;
        const float r0 = __builtin_amdgcn_rsqf(ss_val(rowss_v[tok0 + s0]) * (1.f / 512.f) + EPS), r1 = __builtin_amdgcn_rsqf(ss_val(rowss_v[tok0 + s0 + 1]) * (1.f / 512.f) + EPS);
        const u32x4 va = *(const u32x4*)(PROJ + (size_t)(tok0 + s0) * NPROJ + 512 + g * 64 + 8 * cc);
        const u32x4 vb = *(const u32x4*)(PROJ + (size_t)(tok0 + s0 + 1) * NPROJ + 512 + g * 64 + 8 * cc);
#pragma unroll
        for (int i = 0; i < 4; ++i) {
            VT32[(8 * cc + 2 * i) * (VS / 2) + (s0 >> 1)] = pk2(bf_lo(va[i]) * r0, bf_lo(vb[i]) * r1);
            VT32[(8 * cc + 2 * i + 1) * (VS / 2) + (s0 >> 1)] = pk2(bf_hi(va[i]) * r0, bf_hi(vb[i]) * r1);
        }
    }
    LDS_WAIT(); asm volatile("" ::: "memory");
    const int fr = lane & 15, fq = lane >> 4;
    const bf16* wsg = wsb + (size_t)g * 128 * 128;
    gmlp_half<0>(wl, PROJ, wsg, norm_v, b_s, Y, tok0, g, fr, fq);
    gmlp_half<1>(wl, PROJ, wsg, norm_v, b_s, Y, tok0, g, fr, fq);
    LDS_WAIT(); asm volatile("" ::: "memory");
}

__device__ __forceinline__ void gla_upd_unit(LAS unsigned char* wl, const bf16* PROJ, const float* R, const float* w_gk2, const float* b_gk, float* UPD, float* DEC, int unit, int lane) {
    constexpr int KS = 72;
    LAS unsigned* KD32 = (LAS unsigned*)wl; LAS unsigned* VB32 = (LAS unsigned*)(wl + 9216);
    const int h = unit & 3, tok0 = (unit >> 2) * 64, kk = lane;
    { const f32x4* rp = (const f32x4*)(R + (size_t)(tok0 + lane) * 16); LAS f32x4* rl = (LAS f32x4*)(wl + 9216) + lane * 4;
      const f32x4 r0 = rp[0], r1 = rp[1], r2 = rp[2], r3 = rp[3]; rl[0] = r0; rl[1] = r1; rl[2] = r2; rl[3] = r3; }
    const bf16* kp = PROJ + (size_t)tok0 * NPROJ + 1280 + h * 64 + kk;
    unsigned short kv0[32], kv1[32];
#pragma unroll
    for (int t = 0; t < 32; ++t) kv0[t] = kp[(size_t)t * NPROJ];
    float w[16];
#pragma unroll
    for (int j = 0; j < 16; ++j) w[j] = w_gk2[j * 256 + h * 64 + kk];
    const float bias = b_gk[h * 64 + kk];
    LDS_WAIT(); asm volatile("" ::: "memory");
    float la[64]; float tot = 0.f;
#pragma unroll
    for (int t = 0; t < 64; ++t) {
        const LAS f32x4* rr = (const LAS f32x4*)(wl + 9216) + t * 4;
        float z = bias;
#pragma unroll
        for (int q = 0; q < 4; ++q) { const f32x4 rv = rr[q]; z += rv[0] * w[4 * q] + rv[1] * w[4 * q + 1] + rv[2] * w[4 * q + 2] + rv[3] * w[4 * q + 3]; }
        la[t] = (fminf(z, 0.f) - __logf(1.0f + __expf(-fabsf(z)))) * (1.0f / 16.0f);
        tot += la[t];
    }
    DEC[(size_t)unit * 64 + kk] = __expf(tot);
#pragma unroll
    for (int t = 0; t < 32; ++t) kv1[t] = kp[(size_t)(t + 32) * NPROJ];
    float run = 0.f;
#pragma unroll
    for (int t = 0; t < 32; t += 2) {
        run += la[t]; const float d0 = bf2f(kv0[t]) * __expf(tot - run);
        run += la[t + 1]; const float d1 = bf2f(kv0[t + 1]) * __expf(tot - run);
        KD32[kk * (KS / 2) + (t >> 1)] = pk2(d0, d1);
    }
#pragma unroll
    for (int t = 0; t < 32; t += 2) {
        run += la[32 + t]; const float d0 = bf2f(kv1[t]) * __expf(tot - run);
        run += la[33 + t]; const float d1 = bf2f(kv1[t + 1]) * __expf(tot - run);
        KD32[kk * (KS / 2) + 16 + (t >> 1)] = pk2(d0, d1);
    }
    LDS_WAIT(); asm volatile("" ::: "memory");
    const int fr = lane & 15, fq = lane >> 4, sp = lane >> 3, cc = lane & 7;
#pragma unroll 1
    for (int vh = 0; vh < 2; ++vh) {
#pragma unroll
        for (int it = 0; it < 4; ++it) {
            const int t0 = it * 16 + 2 * sp;
            const u32x4 va = *(const u32x4*)(PROJ + (size_t)(tok0 + t0) * NPROJ + 1536 + h * 128 + vh * 64 + 8 * cc);
            const u32x4 vb = *(const u32x4*)(PROJ + (size_t)(tok0 + t0 + 1) * NPROJ + 1536 + h * 128 + vh * 64 + 8 * cc);
#pragma unroll
            for (int i = 0; i < 4; ++i) {
                VB32[(8 * cc + 2 * i) * (KS / 2) + (t0 >> 1)] = (va[i] & 0xffffu) | (vb[i] << 16);
                VB32[(8 * cc + 2 * i + 1) * (KS / 2) + (t0 >> 1)] = (va[i] >> 16) | (vb[i] & 0xffff0000u);
            }
        }
        LDS_WAIT(); asm volatile("" ::: "memory");
        f32x4 acc[4][4];
#pragma unroll
        for (int i = 0; i < 4; ++i)
#pragma unroll
            for (int j = 0; j < 4; ++j) acc[i][j] = (f32x4){0.f, 0.f, 0.f, 0.f};
#pragma unroll
        for (int ki = 0; ki < 2; ++ki) {
            bf16x8 av[4], bk[4];
#pragma unroll
            for (int mi = 0; mi < 4; ++mi) av[mi] = *(const LAS bf16x8*)(wl + 9216 + ((16 * mi + fr) * KS + 32 * ki + 8 * fq) * 2);
#pragma unroll
            for (int ni = 0; ni < 4; ++ni) bk[ni] = *(const LAS bf16x8*)(wl + ((16 * ni + fr) * KS + 32 * ki + 8 * fq) * 2);
#pragma unroll
            for (int mi = 0; mi < 4; ++mi)
#pragma unroll
                for (int ni = 0; ni < 4; ++ni) acc[mi][ni] = __builtin_amdgcn_mfma_f32_16x16x32_bf16(bk[ni], av[mi], acc[mi][ni], 0, 0, 0);
        }
        float* up = UPD + (size_t)unit * 8192 + (size_t)(vh * 64) * 64;
#pragma unroll
        for (int mi = 0; mi < 4; ++mi)
#pragma unroll
            for (int ni = 0; ni < 4; ++ni) *(f32x4*)(up + (16 * mi + fr) * 64 + 16 * ni + 4 * fq) = acc[mi][ni];
        LDS_WAIT(); asm volatile("" ::: "memory");
    }
}

__device__ __forceinline__ void gla_scan(const float* UPD, const float* DEC, bf16* ST, int gtid, int gthreads) {
    for (int p = gtid; p < 4 * 128 * 16; p += gthreads) {
        const int h = p >> 11, rem = p & 2047, v = rem >> 4, kq = rem & 15;
        f32x4 s = (f32x4){0.f, 0.f, 0.f, 0.f};
#pragma unroll 1
        for (int c0 = 0; c0 < 64; c0 += 16) {
            f32x4 dv[16], uv[16];
#pragma unroll
            for (int i = 0; i < 16; ++i) { const size_t unit = (size_t)((c0 + i) * 4 + h); dv[i] = *(const f32x4*)(DEC + unit * 64 + 4 * kq); uv[i] = *(const f32x4*)(UPD + unit * 8192 + v * 64 + 4 * kq); }
            asm volatile("" : "+v"(dv[0]), "+v"(dv[1]), "+v"(dv[2]), "+v"(dv[3]), "+v"(dv[4]), "+v"(dv[5]), "+v"(dv[6]), "+v"(dv[7]) :: "memory");
            asm volatile("" : "+v"(dv[8]), "+v"(dv[9]), "+v"(dv[10]), "+v"(dv[11]), "+v"(dv[12]), "+v"(dv[13]), "+v"(dv[14]), "+v"(dv[15]) :: "memory");
            asm volatile("" : "+v"(uv[0]), "+v"(uv[1]), "+v"(uv[2]), "+v"(uv[3]), "+v"(uv[4]), "+v"(uv[5]), "+v"(uv[6]), "+v"(uv[7]) :: "memory");
            asm volatile("" : "+v"(uv[8]), "+v"(uv[9]), "+v"(uv[10]), "+v"(uv[11]), "+v"(uv[12]), "+v"(uv[13]), "+v"(uv[14]), "+v"(uv[15]) :: "memory");
#pragma unroll
            for (int i = 0; i < 16; ++i) {
                const size_t unit = (size_t)((c0 + i) * 4 + h);
                s = dv[i] * s + uv[i];
                u32x2 w; w.x = pk2(s[0], s[1]); w.y = pk2(s[2], s[3]);
                *(u32x2*)(ST + unit * 8192 + v * 64 + 4 * kq) = w;
            }
        }
    }
}

__device__ __forceinline__ void gla_out_unit(const bf16* PROJ, const bf16* ST, const float* norm_o, bf16* Y, int unit, int lane) {
    const int h = unit & 3, tok0 = (unit >> 2) * 64, fr = lane & 15, fq = lane >> 4;
    f32x4 acc[8][4];
#pragma unroll
    for (int i = 0; i < 8; ++i)
#pragma unroll
        for (int j = 0; j < 4; ++j) acc[i][j] = (f32x4){0.f, 0.f, 0.f, 0.f};
    const bf16* st = ST + (size_t)unit * 8192;
#pragma unroll 1
    for (int ki = 0; ki < 2; ++ki) {
        bf16x8 bq[4], as[8];
#pragma unroll
        for (int ni = 0; ni < 4; ++ni) bq[ni] = *(const bf16x8*)(PROJ + (size_t)(tok0 + 16 * ni + fr) * NPROJ + 1024 + h * 64 + 32 * ki + 8 * fq);
#pragma unroll
        for (int mi = 0; mi < 8; ++mi) as[mi] = *(const bf16x8*)(st + (16 * mi + fr) * 64 + 32 * ki + 8 * fq);
        asm volatile("" : "+v"(as[0]), "+v"(as[1]), "+v"(as[2]), "+v"(as[3]), "+v"(as[4]), "+v"(as[5]), "+v"(as[6]), "+v"(as[7]), "+v"(bq[0]), "+v"(bq[1]), "+v"(bq[2]), "+v"(bq[3]));
#pragma unroll
        for (int mi = 0; mi < 8; ++mi)
#pragma unroll
            for (int ni = 0; ni < 4; ++ni) acc[mi][ni] = __builtin_amdgcn_mfma_f32_16x16x32_bf16(as[mi], bq[ni], acc[mi][ni], 0, 0, 0);
    }
    f32x4 nov[8];
#pragma unroll
    for (int mi = 0; mi < 8; ++mi) nov[mi] = *(const f32x4*)(norm_o + h * 128 + 16 * mi + 4 * fq);
#pragma unroll
    for (int ni = 0; ni < 4; ++ni) {
        u32x2 gg1[8];
#pragma unroll
        for (int mi = 0; mi < 8; ++mi) gg1[mi] = *(const u32x2*)(PROJ + (size_t)(tok0 + 16 * ni + fr) * NPROJ + 2048 + h * 128 + 16 * mi + 4 * fq);
        asm volatile("" : "+v"(gg1[0]), "+v"(gg1[1]), "+v"(gg1[2]), "+v"(gg1[3]), "+v"(gg1[4]), "+v"(gg1[5]), "+v"(gg1[6]), "+v"(gg1[7]));
        float ss = 0.f;
#pragma unroll
        for (int mi = 0; mi < 8; ++mi) { acc[mi][ni] = acc[mi][ni] * 0.125f; const f32x4 o = acc[mi][ni]; ss += (o[0] * o[0] + o[1] * o[1]) + (o[2] * o[2] + o[3] * o[3]); }
        ss += __shfl_xor(ss, 16); ss += __shfl_xor(ss, 32);
        const float rs = __builtin_amdgcn_rsqf(ss * (1.f / 128.f) + EPS);
        const size_t tok = (size_t)(tok0 + 16 * ni + fr);
#pragma unroll
        for (int mi = 0; mi < 8; ++mi) {
            const int v = h * 128 + 16 * mi + 4 * fq;
            const f32x4 no = nov[mi]; const u32x2 g2 = gg1[mi];
            const f32x4 o = acc[mi][ni];
            const float y0 = o[0] * rs * no[0] * silu_f(bf_lo(g2.x)), y1 = o[1] * rs * no[1] * silu_f(bf_hi(g2.x));
            const float y2 = o[2] * rs * no[2] * silu_f(bf_lo(g2.y)), y3 = o[3] * rs * no[3] * silu_f(bf_hi(g2.y));
            u32x2 w; w.x = pk2(y0, y1); w.y = pk2(y2, y3);
            *(u32x2*)(Y + tok * D + 512 + v) = w;
        }
    }
}

#define XB_TMO      128
#define XB_XCNT(j)  (256  + 64 * (j))
#define XB_XSUB(j)  (1280 + 64 * (j))
#define XB_XGEN(j)  (2304 + 64 * (j))
#define XB_TOP      3328
#define XB_TOPGEN   3392
#define XCD_BAR_WORDS 3456
#define XB_SPIN_CAP (1u << 18)

__device__ __forceinline__ unsigned xb_ld(unsigned* p)              { return __hip_atomic_load(p, __ATOMIC_RELAXED, __HIP_MEMORY_SCOPE_AGENT); }
__device__ __forceinline__ unsigned xb_add(unsigned* p, unsigned v) { return __hip_atomic_fetch_add(p, v, __ATOMIC_RELAXED, __HIP_MEMORY_SCOPE_AGENT); }
__device__ __forceinline__ unsigned xb_xcc_id() { return (unsigned)__builtin_amdgcn_s_getreg((3 << 11) | 20) & 0xFu; }
#define XB_SPIN(cond, bar) do { unsigned _sp = 0; while (cond) { __builtin_amdgcn_s_sleep(1); \
    if ((++_sp & 255u) == 0u) { if (xb_ld(&(bar)[XB_TMO])) break; if (_sp > XB_SPIN_CAP) { atomicAdd(&(bar)[XB_TMO], 1u); break; } } } } while (0)

struct XcdBarrier {
    unsigned* bar; unsigned x; unsigned gsz;
    volatile LAS unsigned* st;
};

__device__ __forceinline__ XcdBarrier xcd_barrier_post(unsigned* bar, volatile LAS unsigned* st, unsigned gsz) {
    XcdBarrier b; b.bar = bar; b.x = xb_xcc_id(); b.st = st; b.gsz = gsz;
    if (threadIdx.x == 0) (void)xb_add(&bar[XB_XCNT(b.x)], 1u);
    return b;
}
__device__ __forceinline__ void xcd_barrier_complete(unsigned* bar, unsigned x, unsigned G, unsigned& nloc, unsigned& nx) {
    unsigned sum, cnt, mine, sp = 0u;
    for (;;) {
        sum = 0u; cnt = 0u; mine = 0u;
#pragma unroll
        for (unsigned j = 0; j < 16; ++j) { const unsigned c = xb_ld(&bar[XB_XCNT(j)]); sum += c; cnt += (c > 0u) ? 1u : 0u; mine = (j == x) ? c : mine; }
        if (sum == G) break;
        __builtin_amdgcn_s_sleep(1);
        if ((++sp & 255u) == 0u) { if (xb_ld(&bar[XB_TMO])) break; if (sp > XB_SPIN_CAP) { atomicAdd(&bar[XB_TMO], 1u); break; } }
    }
    nloc = mine > 0u ? mine : 1u; nx = cnt > 0u ? cnt : 1u;
}

__device__ __forceinline__ void xcd_barrier(const XcdBarrier& b) {
    asm volatile("s_waitcnt vmcnt(0)" ::: "memory");
    __syncthreads();
    if (threadIdx.x == 0) {
        unsigned* bar = b.bar;
        __builtin_amdgcn_s_waitcnt(0);
        unsigned nloc = b.st[0], nx = b.st[1];
        if (nloc == 0u) { xcd_barrier_complete(bar, b.x, b.gsz, nloc, nx); b.st[0] = nloc; b.st[1] = nx; }
        const unsigned old = xb_add(&bar[XB_XSUB(b.x)], 1u);
        const unsigned gen = old / nloc;
        if (old + 1u == (gen + 1u) * nloc) {
            __builtin_amdgcn_fence(__ATOMIC_RELEASE, "agent");
            asm volatile("s_waitcnt vmcnt(0)" ::: "memory");
            const unsigned og = xb_add(&bar[XB_TOP], 1u);
            const unsigned tg = og / nx;
            if (og + 1u == (tg + 1u) * nx) xb_add(&bar[XB_TOPGEN], 1u);
            else XB_SPIN(xb_ld(&bar[XB_TOPGEN]) == tg, bar);
            __builtin_amdgcn_fence(__ATOMIC_ACQUIRE, "agent");
            xb_add(&bar[XB_XGEN(b.x)], 1u);
            asm volatile("s_waitcnt vmcnt(0)" ::: "memory");
        } else {
            XB_SPIN(xb_ld(&bar[XB_XGEN(b.x)]) == gen, bar);
            __builtin_amdgcn_fence(__ATOMIC_ACQUIRE, "agent");
            asm volatile("s_waitcnt vmcnt(0)" ::: "memory");
        }
    }
    __syncthreads();
}

#define IN(k) (lo <= (k) && (k) < hi)
#define SEAM(k) do { if (IN(k) && IN((k) + 1)) xcd_barrier(bar); } while (0)
template <int L>
__device__ __forceinline__ void layer(const Args& a, LAS unsigned char* lds, const XcdBarrier& bar, int lo, int hi, int wave, int lane, int b, int r, int GS) {
    constexpr int P = 1 + 9 * L;
    const int gw = r * NWAVES + wave, NGW = GS * NWAVES;
    const size_t tb = (size_t)b * SEQ;
    unsigned char* ws = a.ws;
    u64* rowss = (u64*)(ws + WS_ROWSS) + tb;
    bf16* XN = (bf16*)(ws + WS_XN) + tb * D; bf16* HB = (bf16*)(ws + WS_H) + tb * NPROJ; bf16* YB = (bf16*)(ws + WS_Y) + tb * D;
    float* RB = (float*)(ws + WS_R) + tb * 16;
    float* UPD = (float*)(ws + WS_UPD) + (size_t)b * 256 * 8192; float* DEC = (float*)(ws + WS_DEC) + (size_t)b * 256 * 64; bf16* ST = (bf16*)(ws + WS_ST) + (size_t)b * 256 * 8192;
    unsigned char* wl = ws + WS_W + (size_t)L * W_L;
    if (IN(P + 0)) {
        pg8::Gemm g{XN, (const bf16*)(wl + W1_OFF), SEQ, NFF, D}; pg8::GroupOrder S; S.init(SEQ, NFF, GS, r);
        pg8::EpiSwiglu E{HB, DFF, rowss + (size_t)(3 * L + 0) * M, 1.f / D, EPS};
        pg8::gemm_phase<pg8::EpiSwiglu, pg8::GroupOrder, true, true>(lds, g, S, E);
    }
    SEAM(P + 0);
    if (IN(P + 1)) {
        pg8::Gemm g{HB, (const bf16*)(wl + W2_OFF), SEQ, D, DFF}; pg8::GroupOrder S; S.init(SEQ, D, GS, r);
        pg8::EpiResid E{L == 0 ? a.in[0] + tb * D : nullptr, XN, rowss + (size_t)(3 * L + 1) * M, 0.5f, D};
        pg8::gemm_phase<pg8::EpiResid, pg8::GroupOrder, true, true>(lds, g, S, E);
    }
    SEAM(P + 1);
    if (IN(P + 2)) {
        pg8::Gemm g{XN, (const bf16*)(wl + WIN_OFF), SEQ, 2560, D}; pg8::GroupOrder S; S.init(SEQ, 2560, GS, r);
        pg8::EpiProj E{HB, NPROJ, rowss + (size_t)(3 * L + 1) * M, rowss + (size_t)(7 + L) * M, RB, 1.f / D, EPS};
        pg8::gemm_phase<pg8::EpiProj, pg8::GroupOrder, true, true>(lds, g, S, E);
        for (int u = gw; u < SEQ / 16; u += NGW) rank_unit(XN, (const bf16*)(wl + WIN_OFF) + (size_t)2560 * D, rowss + (size_t)(3 * L + 1) * M, RB, u * 16, lane);
    }
    SEAM(P + 2);
    if (IN(P + 3)) {
        LAS unsigned char* wlds = lds + wave * WAVE_LDS;
        for (int u = gw; u < 256; u += NGW)
            gmlp_unit(wlds, HB, rowss + (size_t)(7 + L) * M, (const bf16*)(ws + WS_WSB) + (size_t)L * 8 * 128 * 128, a.in[6] + L * 512, a.in[8] + L * 1024, YB, u >> 3, u & 7, lane);
        for (int u = gw; u < 256; u += NGW)
            gla_upd_unit(wlds, HB, RB, a.in[9] + L * 16 * 256, a.in[10] + L * 256, UPD, DEC, u, lane);
    }
    SEAM(P + 3);
    if (IN(P + 4)) { if (threadIdx.x < NTHREADS / 2) gla_scan(UPD, DEC, ST, r * (NTHREADS / 2) + (int)threadIdx.x, GS * (NTHREADS / 2)); }
    SEAM(P + 4);
    if (IN(P + 5)) { for (int u = gw; u < 256; u += NGW) gla_out_unit(HB, ST, a.in[11] + L * 512, YB, u, lane); }
    SEAM(P + 5);
    if (IN(P + 6)) {
        pg8::Gemm g{YB, (const bf16*)(wl + WOUT_OFF), SEQ, D, D}; pg8::GroupOrder S; S.init(SEQ, D, GS, r);
        pg8::EpiResid E{nullptr, XN, rowss + (size_t)(3 * L + 2) * M, 1.0f, D};
        pg8::gemm_phase<pg8::EpiResid, pg8::GroupOrder, true, true>(lds, g, S, E);
    }
    SEAM(P + 6);
    if (IN(P + 7)) {
        pg8::Gemm g{XN, (const bf16*)(wl + W3_OFF), SEQ, NFF, D}; pg8::GroupOrder S; S.init(SEQ, NFF, GS, r);
        pg8::EpiSwiglu E{HB, DFF, rowss + (size_t)(3 * L + 2) * M, 1.f / D, EPS};
        pg8::gemm_phase<pg8::EpiSwiglu, pg8::GroupOrder, true, true>(lds, g, S, E);
    }
    SEAM(P + 7);
    if (IN(P + 8)) {
        pg8::Gemm g{HB, (const bf16*)(wl + W4_OFF), SEQ, D, DFF}; pg8::GroupOrder S; S.init(SEQ, D, GS, r);
        pg8::EpiResid E{nullptr, XN, rowss + (size_t)(3 * L + 3) * M, 0.5f, D};
        pg8::gemm_phase<pg8::EpiResid, pg8::GroupOrder, true, true>(lds, g, S, E);
    }
    SEAM(P + 8);
}

__global__ void __launch_bounds__(NTHREADS, 2) fwd(Args a) {
    extern __shared__ __attribute__((aligned(16))) unsigned char lds_raw[];
    LAS unsigned char* lds = (LAS unsigned char*)lds_raw;
    const int tid = threadIdx.x, lane = tid & 63, wave = __builtin_amdgcn_readfirstlane(tid >> 6);
    const int lo = a.ph_lo, hi = a.ph_hi;
    if (tid < 64) ((LAS unsigned*)(lds + MISC_OFF))[tid] = 0u;
    __syncthreads();
    const int G = gridDim.x, GS = G / NGRP, b = (int)blockIdx.x % NGRP, r = (int)blockIdx.x / NGRP;
    const bool in_group = r < GS;
    XcdBarrier gbar = xcd_barrier_post((unsigned*)a.ws + NGRP * XCD_BAR_WORDS, (volatile LAS unsigned*)(lds + MISC_OFF), (unsigned)G);
    XcdBarrier bar = gbar;
    if (in_group) bar = xcd_barrier_post((unsigned*)a.ws + b * XCD_BAR_WORDS, (volatile LAS unsigned*)(lds + MISC_OFF) + 2, (unsigned)GS);
    if (IN(0)) prologue(a, lds, wave, lane);
    if (lo < 0) cg::this_grid().sync();
    if (IN(0) && IN(1)) xcd_barrier(gbar);
    if (!in_group) return;
    layer<0>(a, lds, bar, lo, hi, wave, lane, b, r, GS);
    layer<1>(a, lds, bar, lo, hi, wave, lane, b, r, GS);
    if (IN(NPHASE - 1)) {
        const int gw = r * NWAVES + wave, NGW = GS * NWAVES; const size_t tb = (size_t)b * SEQ;
        const float* fw = a.in[16]; const u64* rs6 = (const u64*)(a.ws + WS_ROWSS) + (size_t)6 * M + tb; const bf16* XN = (const bf16*)(a.ws + WS_XN) + tb * D; float* outb = a.out + tb * D;
        f32x4 wv[2][2];
#pragma unroll
        for (int j = 0; j < 2; ++j) { wv[j][0] = *((const f32x4*)fw + 2 * (lane + 64 * j)); wv[j][1] = *((const f32x4*)fw + 2 * (lane + 64 * j) + 1); }
        for (int m = gw; m < SEQ; m += 2 * NGW) {
            const int m1 = m + NGW; const bool two = m1 < SEQ;
            u32x4 xv[2][2]; u64 sv[2];
            sv[0] = rs6[m]; sv[1] = two ? rs6[m1] : sv[0];
#pragma unroll
            for (int j = 0; j < 2; ++j) { xv[0][j] = *((const u32x4*)(XN + (size_t)m * D) + lane + 64 * j); xv[1][j] = two ? *((const u32x4*)(XN + (size_t)m1 * D) + lane + 64 * j) : xv[0][j]; }
            asm volatile("" : "+v"(xv[0][0]), "+v"(xv[0][1]), "+v"(xv[1][0]), "+v"(xv[1][1]), "+v"(sv[0]), "+v"(sv[1]) :: "memory");
#pragma unroll
            for (int r2 = 0; r2 < 2; ++r2) {
                if (r2 == 1 && !two) break;
                const float rs = __builtin_amdgcn_rsqf(ss_val(sv[r2]) * (1.f / D) + EPS);
                f32x4* orow = (f32x4*)(outb + (size_t)(r2 ? m1 : m) * D);
#pragma unroll
                for (int j = 0; j < 2; ++j) {
                    const u32x4 x4 = xv[r2][j]; const f32x4 w0 = wv[j][0], w1 = wv[j][1];
                    f32x4 o0, o1;
                    o0[0] = bf_lo(x4[0]) * rs * w0[0]; o0[1] = bf_hi(x4[0]) * rs * w0[1]; o0[2] = bf_lo(x4[1]) * rs * w0[2]; o0[3] = bf_hi(x4[1]) * rs * w0[3];
                    o1[0] = bf_lo(x4[2]) * rs * w1[0]; o1[1] = bf_hi(x4[2]) * rs * w1[1]; o1[2] = bf_lo(x4[3]) * rs * w1[2]; o1[3] = bf_hi(x4[3]) * rs * w1[3];
                    orow[2 * (lane + 64 * j)] = o0; orow[2 * (lane + 64 * j) + 1] = o1;
                }
            }
        }
    }
}

extern "C" void kernel_launch(void* const* d_in, const int* in_sizes, int n_in, void* d_out, int out_size, void* d_ws, size_t ws_size, hipStream_t stream) {
    static int grid = 0;
    if (grid == 0) {
        if (n_in != 17 || in_sizes[0] != M * D || out_size != M * D || ws_size < WS_END) { fprintf(stderr, "kernel_launch: unexpected problem (n_in %d, in0 %d, out %d, ws %zu)\n", n_in, n_in > 0 ? in_sizes[0] : -1, out_size, ws_size); grid = -1; return; }
        int dev = 0, cus = 0, per_cu = 0;
        (void)hipGetDevice(&dev); (void)hipDeviceGetAttribute(&cus, hipDeviceAttributeMultiprocessorCount, dev);
        if (hipFuncSetAttribute((const void*)fwd, hipFuncAttributeMaxDynamicSharedMemorySize, LDS_BYTES) != hipSuccess) { fprintf(stderr, "kernel_launch: hipFuncSetAttribute failed\n"); grid = -1; return; }
        if (hipOccupancyMaxActiveBlocksPerMultiprocessor(&per_cu, (const void*)fwd, NTHREADS, LDS_BYTES) != hipSuccess || per_cu < 1) { fprintf(stderr, "kernel_launch: occupancy query says %d\n", per_cu); per_cu = 1; }
        (void)hipGetLastError();
        grid = cus * per_cu;
    }
    if (grid < 0) return;
    if (hipMemsetAsync(d_ws, 0, 131072, stream) != hipSuccess) { fprintf(stderr, "kernel_launch: memset of the barrier words failed\n"); return; }
    Args a{};
    for (int i = 0; i < 17; ++i) a.in[i] = (const float*)d_in[i];
    a.out = (float*)d_out; a.ws = (unsigned char*)d_ws;
#if MK_MULTI
#ifndef DUPMASK
#define DUPMASK 0
#endif
    for (int ph = 0; ph < NPHASE; ++ph) { a.ph_lo = ph; a.ph_hi = ph + 1; hipLaunchKernelGGL(fwd, dim3(grid), dim3(NTHREADS), LDS_BYTES, stream, a);
        const int bit = ph == 0 ? 9 : (ph == NPHASE - 1 ? 10 : (ph - 1) % 9);
        if ((DUPMASK >> bit) & 1) hipLaunchKernelGGL(fwd, dim3(grid), dim3(NTHREADS), LDS_BYTES, stream, a); }
#else
    a.ph_lo = 0; a.ph_hi = NPHASE;
    void* args[] = {&a};
    hipError_t e = hipLaunchCooperativeKernel((const void*)fwd, dim3(grid), dim3(NTHREADS), args, LDS_BYTES, stream);
    if (e != hipSuccess) fprintf(stderr, "cooperative launch failed: %s (grid %d)\n", hipGetErrorString(e), grid);
#endif
}
```

```cpp
#include <hip/hip_runtime.h>
#include <hip/hip_cooperative_groups.h>
#include <cstdio>
#include <cstdint>
namespace cg = cooperative_groups;
namespace pg8 {
#define PG8_LAS __attribute__((address_space(3)))
typedef unsigned short bf16_t;
typedef short bf16x8 __attribute__((ext_vector_type(8)));
typedef float f32x4 __attribute__((ext_vector_type(4)));
typedef unsigned u32x4 __attribute__((ext_vector_type(4)));
constexpr int BM = 256, BK = 64, HALF = 128, HTB = HALF * BK * 2  , STAGE_BYTES = 8 * HTB, NXCD = 8, WGM = 4;

__host__ __device__ __forceinline__ int lds_byte(int r, int c) { const int st = (r >> 4) * 2 + (c >> 5), rr = r & 15, cc = c & 31, ob = rr * 64 + cc * 2; return st * 1024 + (ob ^ (((ob >> 9) & 1) << 5)); }
__host__ __device__ __forceinline__ void stage_rc(int b, int& R, int& C) { const int st = b / 1024, sb = b % 1024, swz = sb ^ (((sb >> 9) & 1) << 5); R = (st >> 1) * 16 + swz / 64; C = (st & 1) * 32 + (swz % 64) / 2; }
__host__ __device__ __forceinline__ int perm32(int rho) { const int n = rho >> 4, i = rho & 15; return 8 * (i >> 2) + 4 * n + (i & 3); }

struct Unit { int pm, pn; };
struct Gemm { const bf16_t* A; const bf16_t* Bt; int M, N, K; };

struct StaticOrder {
    int nM, nN, nwg, G, c;
    __host__ __device__ void init(int M, int N, int G_, int c_) { nM = M / BM; nN = N / BM; nwg = nM * nN; G = G_; c = c_; }
    __host__ __device__ bool next(int i, Unit& u) const {
        const long L = (long)i * G + c; if (L >= nwg) return false;
        int wgid = (int)L; { const int q = nwg / NXCD, r = nwg % NXCD, xcd = wgid % NXCD, off = wgid / NXCD; wgid = (xcd < r ? xcd * (q + 1) : r * (q + 1) + (xcd - r) * q) + off; }
        const int nig = WGM * nN, gid = wgid / nig, fm = gid * WGM, gsz = (nM - fm) < WGM ? (nM - fm) : WGM;
        u.pm = fm + ((wgid % nig) % gsz); u.pn = (wgid % nig) / gsz; return true;
    }
    __device__ __forceinline__ void a_ready(const Unit&) const {}
    __device__ __forceinline__ void done(const Unit&) const {}
};

struct GroupOrder {
    int nM, nN, nwg, G, c;
    __host__ __device__ void init(int M, int N, int G_, int c_) { nM = M / BM; nN = N / BM; nwg = nM * nN; G = G_; c = c_; }
    __host__ __device__ bool next(int i, Unit& u) const {
        const int L = i * G + c; if (L >= nwg) return false;
        const int nig = WGM * nN, gid = L / nig, fm = gid * WGM, gsz = (nM - fm) < WGM ? (nM - fm) : WGM;
        u.pm = fm + ((L % nig) % gsz); u.pn = (L % nig) / gsz; return true;
    }
    __device__ __forceinline__ void a_ready(const Unit&) const {}
    __device__ __forceinline__ void done(const Unit&) const {}
};

__device__ __forceinline__ unsigned cvt_pk_bf16(float lo, float hi) { unsigned r; asm volatile("v_cvt_pk_bf16_f32 %0, %1, %2" : "=v"(r) : "v"(lo), "v"(hi)); return r; }
typedef unsigned u32x2 __attribute__((ext_vector_type(2)));
typedef unsigned long long u64;
typedef float f32x2v __attribute__((ext_vector_type(2)));
__device__ __forceinline__ u64 ss_fix(float s) { return (u64)(s * 1099511627776.0f); }
__device__ __forceinline__ float ss_val(u64 v) { return (float)v * (1.0f / 1099511627776.0f); }
__device__ __forceinline__ float fast_silu(float g) { return g * __builtin_amdgcn_rcpf(1.0f + __expf(-g)); }
struct EpiSwiglu {
    static constexpr bool PERM = true, AFTER_DRAIN = false;
    bf16_t* O; int ldc; const u64* rowss; float inv_k, eps;
    __device__ __forceinline__ void operator()(const f32x4 (&acc)[2][2][4][2], const Unit& u, const Unit& nxt, bool has_next, int wr, int wc, int fr, int fq) const {
        const int row0 = u.pm * BM + wr * 64 + fr, col0 = u.pn * HALF + wc * 32 + 8 * fq;
        u64 cur[8];
#pragma unroll
        for (int g = 0; g < 8; ++g) cur[g] = rowss[row0 + (g >> 2) * HALF + (g & 3) * 16];
#pragma unroll
        for (int g = 0; g < 8; ++g) {
            const int ai = g >> 2, m = g & 3;
            const float rs = __builtin_amdgcn_rsqf(ss_val(cur[g]) * inv_k + eps), rsn = rs * -1.44269504089f, rs2 = rs * rs;
            float h[8];
#pragma unroll
            for (int n = 0; n < 2; ++n)
#pragma unroll
                for (int jp = 0; jp < 2; ++jp) {
                    const f32x2v av = {acc[ai][0][m][n][2 * jp], acc[ai][0][m][n][2 * jp + 1]}, gv = {acc[ai][1][m][n][2 * jp], acc[ai][1][m][n][2 * jp + 1]};
                    const f32x2v t = (av * gv) * rs2, y = gv * rsn;
                    f32x2v ex; ex.x = __builtin_amdgcn_exp2f(y.x); ex.y = __builtin_amdgcn_exp2f(y.y);
                    const f32x2v d = ex + 1.0f;
                    f32x2v r; r.x = __builtin_amdgcn_rcpf(d.x); r.y = __builtin_amdgcn_rcpf(d.y);
                    const f32x2v o = t * r;
                    h[4 * n + 2 * jp] = o.x; h[4 * n + 2 * jp + 1] = o.y;
                }
            u32x4 w; w.x = cvt_pk_bf16(h[0], h[1]); w.y = cvt_pk_bf16(h[2], h[3]); w.z = cvt_pk_bf16(h[4], h[5]); w.w = cvt_pk_bf16(h[6], h[7]);
            *(u32x4*)(O + (size_t)(row0 + ai * HALF + m * 16) * ldc + col0) = w;
        }
    }
};
struct EpiResid {
    static constexpr bool PERM = true, AFTER_DRAIN = false;
    const float* base32; bf16_t* xs; u64* rowss; float alpha; int ldc;
    __device__ __forceinline__ void operator()(const f32x4 (&acc)[2][2][4][2], const Unit& u, const Unit&, bool, int wr, int wc, int fr, int fq) const {
        const int row0 = u.pm * BM + wr * 64 + fr, col0 = u.pn * BM + wc * 32 + 8 * fq;
        bf16_t* xp = xs + (size_t)row0 * ldc + col0;
        float ss[8];
        u32x4 pre[3][2];
        if (!base32) {
#pragma unroll
            for (int q = 0; q < 2; ++q)
#pragma unroll
                for (int bj = 0; bj < 2; ++bj) pre[q][bj] = *(const u32x4*)(xp + (size_t)((q >> 2) * HALF + (q & 3) * 16) * ldc + bj * HALF);
        }
#pragma unroll
        for (int g = 0; g < 8; ++g) {
            const int ai = g >> 2, m = g & 3; const size_t roff = (size_t)(ai * HALF + m * 16) * ldc; float s = 0.f;
            if (!base32 && g + 2 < 8) {
#pragma unroll
                for (int bj = 0; bj < 2; ++bj) pre[(g + 2) % 3][bj] = *(const u32x4*)(xp + (size_t)(((g + 2) >> 2) * HALF + ((g + 2) & 3) * 16) * ldc + bj * HALF);
            }
            asm volatile("" ::: "memory");
#pragma unroll
            for (int bj = 0; bj < 2; ++bj) {
                float b[8];
                if (base32) {
                    const f32x4 b0 = *(const f32x4*)(base32 + (size_t)row0 * ldc + col0 + roff + bj * HALF), b1 = *(const f32x4*)(base32 + (size_t)row0 * ldc + col0 + roff + bj * HALF + 4);
                    b[0] = b0[0]; b[1] = b0[1]; b[2] = b0[2]; b[3] = b0[3]; b[4] = b1[0]; b[5] = b1[1]; b[6] = b1[2]; b[7] = b1[3];
                } else {
                    const u32x4 bw = pre[g % 3][bj];
#pragma unroll
                    for (int e = 0; e < 4; ++e) { b[2 * e] = __builtin_bit_cast(float, bw[e] << 16); b[2 * e + 1] = __builtin_bit_cast(float, bw[e] & 0xffff0000u); }
                }
                u32x4 w;
#pragma unroll
                for (int e = 0; e < 4; ++e) {
                    const float o0 = b[2 * e] + acc[ai][bj][m][e >> 1][(2 * e) & 3] * alpha, o1 = b[2 * e + 1] + acc[ai][bj][m][e >> 1][(2 * e + 1) & 3] * alpha;
                    const unsigned pw = cvt_pk_bf16(o0, o1); w[e] = pw;
                    const float r0 = __builtin_bit_cast(float, pw << 16), r1 = __builtin_bit_cast(float, pw & 0xffff0000u);
                    s += r0 * r0 + r1 * r1;
                }
                *(u32x4*)(xp + roff + bj * HALF) = w;
            }
            ss[g] = s;
            asm volatile("" ::: "memory");
        }
#pragma unroll
        for (int g = 0; g < 8; ++g) {
            float s = ss[g]; s += __shfl_xor(s, 16); s += __shfl_xor(s, 32);
            if (fq == 0) atomicAdd(rowss + row0 + (g >> 2) * HALF + (g & 3) * 16, ss_fix(s));
        }
    }
};
struct EpiProj {
    static constexpr bool PERM = true, AFTER_DRAIN = false;
    bf16_t* O; int ldc; const u64* rowss; u64* rowss_v; float* R; float inv_k, eps;
    __device__ __forceinline__ void operator()(const f32x4 (&acc)[2][2][4][2], const Unit& u, const Unit&, bool, int wr, int wc, int fr, int fq) const {
        const int row0 = u.pm * BM + wr * 64 + fr;
        const bool is_va = (u.pn == 2) || (u.pn == 3);
        const int col0 = u.pn * BM + wc * 32 + 8 * fq;
        u64 cur[8];
#pragma unroll
        for (int g = 0; g < 8; ++g) cur[g] = rowss[row0 + (g >> 2) * HALF + (g & 3) * 16];
        asm volatile("" : "+v"(cur[0]), "+v"(cur[1]), "+v"(cur[2]), "+v"(cur[3]), "+v"(cur[4]), "+v"(cur[5]), "+v"(cur[6]), "+v"(cur[7]) :: "memory");
#pragma unroll
        for (int ai = 0; ai < 2; ++ai)
#pragma unroll
            for (int m = 0; m < 4; ++m) {
                const int row = row0 + ai * HALF + m * 16;
                const float rs = __builtin_amdgcn_rsqf(ss_val(cur[ai * 4 + m]) * inv_k + eps);
                float ss = 0.f;
#pragma unroll
                for (int bj = 0; bj < 2; ++bj) {
                    const f32x4 v0 = acc[ai][bj][m][0] * rs, v1 = acc[ai][bj][m][1] * rs;
                    ss += (v0[0] * v0[0] + v0[1] * v0[1]) + (v0[2] * v0[2] + v0[3] * v0[3]) + (v1[0] * v1[0] + v1[1] * v1[1]) + (v1[2] * v1[2] + v1[3] * v1[3]);
                    u32x4 w; w.x = cvt_pk_bf16(v0[0], v0[1]); w.y = cvt_pk_bf16(v0[2], v0[3]); w.z = cvt_pk_bf16(v1[0], v1[1]); w.w = cvt_pk_bf16(v1[2], v1[3]);
                    *(u32x4*)(O + (size_t)row * ldc + col0 + bj * HALF) = w;
                }
                if (is_va) { ss += __shfl_xor(ss, 16); ss += __shfl_xor(ss, 32); if (fq == 0) atomicAdd(rowss_v + row, ss_fix(ss)); }
            }
    }
};
template <class Epi, class Sched, bool ALIGN_EPI = false, bool SP2 = false>
__device__ __forceinline__ void gemm_phase(PG8_LAS unsigned char* lds, const Gemm g, const Sched& S, const Epi& E) {
    const int tid = threadIdx.x, wid = __builtin_amdgcn_readfirstlane(tid >> 6), lane = tid & 63, wr = wid >> 2, wc = wid & 3, fr = lane & 15, fq = lane >> 4;
    const int K = g.K, nt = K / BK;
    unsigned voffA[2], voffB[2];
#pragma unroll
    for (int i = 0; i < 2; ++i) { int R, C; stage_rc(tid * 16 + i * 8192, R, C); const int Rb = Epi::PERM ? ((R & ~31) + perm32(R & 31)) : R;
        voffA[i] = (unsigned)(R * K + C) * 2u; voffB[i] = (unsigned)(Rb * K + C) * 2u; }
    const size_t kstep = (size_t)(BK * 2);
    const size_t hstep = (size_t)HALF * K * 2;
    const size_t tstep = 2 * hstep;
    const unsigned ldsw = (unsigned)wid * 1024u;
    const int aoff = lds_byte(wr * 64 + fr, fq * 8), boff = lds_byte(wc * 32 + fr, fq * 8);
#define PG8_SA(b, h) (((b) * 2 + (h)) * HTB)
#define PG8_SB(b, h) ((4 + (b) * 2 + (h)) * HTB)
#define PG8_STAGE(bufoff, gbase, voff) do { _Pragma("unroll") for (int _i = 0; _i < 2; ++_i) \
        __builtin_amdgcn_global_load_lds((const unsigned*)((const char*)(gbase) + (voff)[_i]), (PG8_LAS unsigned*)(lds + (bufoff) + ldsw + _i * 8192), 16, 0, 0); } while (0)
#define PG8_LDA(dst, b, h) do { _Pragma("unroll") for (int m = 0; m < 4; ++m) _Pragma("unroll") for (int k = 0; k < 2; ++k) dst[m][k] = *(const PG8_LAS bf16x8*)(lds + PG8_SA(b, h) + aoff + m * 2048 + k * 1024); } while (0)
#define PG8_LDB(dst, b, h) do { _Pragma("unroll") for (int n = 0; n < 2; ++n) _Pragma("unroll") for (int k = 0; k < 2; ++k) dst[n][k] = *(const PG8_LAS bf16x8*)(lds + PG8_SB(b, h) + boff + n * 2048 + k * 1024); } while (0)
#define PG8_MMA(ai, bj, At, Bt) do { __builtin_amdgcn_s_setprio(1); _Pragma("unroll") for (int m = 0; m < 4; ++m) _Pragma("unroll") for (int n = 0; n < 2; ++n) _Pragma("unroll") for (int k = 0; k < 2; ++k) \
        acc[ai][bj][m][n] = __builtin_amdgcn_mfma_f32_16x16x32_bf16(Bt[n][k], At[m][k], acc[ai][bj][m][n], 0, 0, 0); __builtin_amdgcn_s_setprio(0); } while (0)
#define PG8_WAIT_V(n) asm volatile("s_waitcnt vmcnt(" #n ")" ::: "memory")
#define PG8_WAIT_L(n) asm volatile("s_waitcnt lgkmcnt(" #n ")" ::: "memory")
#define PG8_BAR __builtin_amdgcn_s_barrier()
#define PG8_SCHED __builtin_amdgcn_sched_barrier(0)
    Unit cur, nxt; int ui = 0;
    if (!S.next(0, cur)) return;
    f32x4 acc[2][2][4][2];
#pragma unroll
    for (int a = 0; a < 2; ++a)
#pragma unroll
        for (int b = 0; b < 2; ++b)
#pragma unroll
            for (int m = 0; m < 4; ++m)
#pragma unroll
                for (int n = 0; n < 2; ++n) acc[a][b][m][n] = (f32x4){0.f, 0.f, 0.f, 0.f};
    bf16x8 At[4][2], B0[2][2], B1[2][2];
    const char* cA = (const char*)g.A + (size_t)cur.pm * tstep; const char* cB = (const char*)g.Bt + (size_t)cur.pn * tstep;
    S.a_ready(cur);
    if constexpr (SP2) {
        PG8_STAGE(PG8_SB(0, 0), cB, voffB); PG8_STAGE(PG8_SB(0, 1), cB + hstep, voffB); PG8_STAGE(PG8_SA(0, 0), cA, voffA); PG8_STAGE(PG8_SA(0, 1), cA + hstep, voffA);
        if (wr == 1) PG8_BAR;
        PG8_WAIT_V(2); PG8_BAR;
        PG8_STAGE(PG8_SB(1, 0), cB + kstep, voffB); PG8_STAGE(PG8_SA(1, 0), cA + kstep, voffA); PG8_STAGE(PG8_SB(1, 1), cB + hstep + kstep, voffB);
        PG8_WAIT_V(6); PG8_BAR;
    } else {
        PG8_STAGE(PG8_SB(0, 0), cB, voffB); PG8_STAGE(PG8_SA(0, 0), cA, voffA); PG8_STAGE(PG8_SB(0, 1), cB + hstep, voffB); PG8_STAGE(PG8_SA(0, 1), cA + hstep, voffA);
        if (wr == 1) PG8_BAR;
        PG8_WAIT_V(4); PG8_BAR;
        PG8_STAGE(PG8_SB(1, 0), cB + kstep, voffB); PG8_STAGE(PG8_SA(1, 0), cA + kstep, voffA); PG8_STAGE(PG8_SB(1, 1), cB + hstep + kstep, voffB);
        PG8_WAIT_V(6); PG8_BAR;
    }
    for (;;) {
        const bool has_next = S.next(ui + 1, nxt);
        const char* nA = has_next ? (const char*)g.A + (size_t)nxt.pm * tstep : cA; const char* nB = has_next ? (const char*)g.Bt + (size_t)nxt.pn * tstep : cB;
        for (int t = 0; t < nt; t += 2) {
            const bool last = (t == nt - 2);
            const char* a1 = cA + (size_t)(t + 1) * kstep;
            const char* a2 = last ? nA : cA + (size_t)(t + 2) * kstep; const char* b2 = last ? nB : cB + (size_t)(t + 2) * kstep;
            const char* a3 = a2 + kstep; const char* b3 = b2 + kstep;
            if (last && has_next) S.a_ready(nxt);
            if constexpr (SP2) {
            PG8_LDB(B0, 0, 0); PG8_LDB(B1, 0, 1); PG8_SCHED; PG8_LDA(At, 0, 0); PG8_STAGE(PG8_SA(1, 1), a1 + hstep, voffA);
            PG8_WAIT_V(8); PG8_WAIT_L(0); PG8_BAR; PG8_MMA(0, 0, At, B0); PG8_MMA(0, 1, At, B1); PG8_BAR; PG8_SCHED;
            PG8_LDA(At, 0, 1); PG8_STAGE(PG8_SB(0, 0), b2, voffB); PG8_STAGE(PG8_SB(0, 1), b2 + hstep, voffB); PG8_STAGE(PG8_SA(0, 0), a2, voffA);
            PG8_WAIT_V(8); PG8_WAIT_L(0); PG8_BAR; PG8_MMA(1, 0, At, B0); PG8_MMA(1, 1, At, B1); PG8_BAR; PG8_SCHED;
            PG8_LDB(B0, 1, 0); PG8_LDB(B1, 1, 1); PG8_SCHED; PG8_LDA(At, 1, 0); PG8_STAGE(PG8_SA(0, 1), a2 + hstep, voffA);
            PG8_WAIT_V(8); PG8_WAIT_L(0); PG8_BAR; PG8_MMA(0, 0, At, B0); PG8_MMA(0, 1, At, B1); PG8_BAR; PG8_SCHED;
            PG8_LDA(At, 1, 1); PG8_STAGE(PG8_SB(1, 0), b3, voffB); PG8_STAGE(PG8_SB(1, 1), b3 + hstep, voffB); PG8_STAGE(PG8_SA(1, 0), a3, voffA);
            PG8_WAIT_V(8); PG8_WAIT_L(0); PG8_BAR; PG8_MMA(1, 0, At, B0); PG8_MMA(1, 1, At, B1); PG8_BAR; PG8_SCHED;
            } else {
            PG8_LDB(B0, 0, 0); PG8_SCHED; PG8_LDA(At, 0, 0); PG8_STAGE(PG8_SA(1, 1), a1 + hstep, voffA);
            PG8_WAIT_L(8); PG8_BAR; PG8_WAIT_L(0); PG8_MMA(0, 0, At, B0); PG8_BAR; PG8_SCHED;
            PG8_LDB(B1, 0, 1); PG8_STAGE(PG8_SB(0, 0), b2, voffB);
            PG8_BAR; PG8_WAIT_L(0); PG8_MMA(0, 1, At, B1); PG8_BAR;
            PG8_LDA(At, 0, 1); PG8_STAGE(PG8_SA(0, 0), a2, voffA);
            PG8_BAR; PG8_WAIT_L(0); PG8_MMA(1, 0, At, B0); PG8_BAR; PG8_SCHED;
            PG8_STAGE(PG8_SB(0, 1), b2 + hstep, voffB);
            PG8_WAIT_V(6); PG8_BAR; PG8_MMA(1, 1, At, B1); PG8_BAR;
            PG8_LDB(B0, 1, 0); PG8_SCHED; PG8_LDA(At, 1, 0); PG8_STAGE(PG8_SA(0, 1), a2 + hstep, voffA);
            PG8_WAIT_L(8); PG8_BAR; PG8_WAIT_L(0); PG8_MMA(0, 0, At, B0); PG8_BAR; PG8_SCHED;
            PG8_LDB(B1, 1, 1); PG8_STAGE(PG8_SB(1, 0), b3, voffB);
            PG8_BAR; PG8_WAIT_L(0); PG8_MMA(0, 1, At, B1); PG8_BAR;
            PG8_LDA(At, 1, 1); PG8_STAGE(PG8_SA(1, 0), a3, voffA);
            PG8_BAR; PG8_WAIT_L(0); PG8_MMA(1, 0, At, B0); PG8_BAR; PG8_SCHED;
            PG8_STAGE(PG8_SB(1, 1), b3 + hstep, voffB);
            PG8_WAIT_V(6); PG8_BAR; PG8_MMA(1, 1, At, B1); PG8_BAR;
            }
        }
        if constexpr (ALIGN_EPI) { if (wr == 0) PG8_BAR; }
        if constexpr (!Epi::AFTER_DRAIN) { E(acc, cur, nxt, has_next, wr, wc, fr, fq); S.done(cur); }
        if (!has_next) break;
#pragma unroll
        for (int a = 0; a < 2; ++a)
#pragma unroll
            for (int b = 0; b < 2; ++b)
#pragma unroll
                for (int m = 0; m < 4; ++m)
#pragma unroll
                    for (int n = 0; n < 2; ++n) acc[a][b][m][n] = (f32x4){0.f, 0.f, 0.f, 0.f};
        cur = nxt; cA = nA; cB = nB; ++ui;
        if constexpr (ALIGN_EPI) { if (wr == 1) PG8_BAR; }
    }
    PG8_WAIT_V(0);
    if constexpr (!ALIGN_EPI) { if (wr == 0) PG8_BAR; }
    PG8_BAR;
    if constexpr (Epi::AFTER_DRAIN) { E.fused(acc, cur, wr, wc, fr, fq, lds, wid, lane); S.done(cur); }
#undef PG8_SA
#undef PG8_SB
#undef PG8_STAGE
#undef PG8_LDA
#undef PG8_LDB
#undef PG8_MMA
#undef PG8_WAIT_V
#undef PG8_WAIT_L
#undef PG8_BAR
#undef PG8_SCHED
}
}
#define LAS __attribute__((address_space(3)))
typedef unsigned short bf16;
typedef float f32x4 __attribute__((ext_vector_type(4)));
typedef float f32x2 __attribute__((ext_vector_type(2)));
typedef unsigned u32x4 __attribute__((ext_vector_type(4)));
typedef unsigned u32x2 __attribute__((ext_vector_type(2)));
typedef short bf16x8 __attribute__((ext_vector_type(8)));
typedef unsigned long long u64;
using pg8::ss_fix; using pg8::ss_val;
#define LDS_WAIT() asm volatile("s_waitcnt lgkmcnt(0)" ::: "memory")

constexpr int NBATCH = 8, SEQ = 4096, D = 1024, M = NBATCH * SEQ, DFF = 2816, NFF = 2 * DFF, NPROJ = 2816, INCOLS = 2576, DEPTH = 2;
constexpr float EPS = 1e-6f;
constexpr int NTHREADS = 512, NWAVES = 8;
constexpr int LDS_BYTES = 147456 + 256, WAVE_LDS = 18432, MISC_OFF = 147456;
constexpr int NPHASE = 20, NGRP = NBATCH;
#ifndef MK_MULTI
#define MK_MULTI 0
#endif

constexpr size_t MiB = 1u << 20;
constexpr size_t WS_ROWSS = 1 * MiB;
constexpr size_t WS_DEC = 4 * MiB;
constexpr size_t WS_R = 5 * MiB;
constexpr size_t WS_WSB = 7 * MiB;
constexpr size_t WS_W = 8 * MiB;
constexpr size_t W_L = 40 * MiB + MiB / 2;
constexpr size_t W1_OFF = 0, W2_OFF = 11 * MiB, WIN_OFF = 16 * MiB + MiB / 2, WOUT_OFF = 22 * MiB, W3_OFF = 24 * MiB, W4_OFF = 35 * MiB;
constexpr size_t WS_XN = 96 * MiB;
constexpr size_t WS_H = 160 * MiB;
constexpr size_t WS_Y = 336 * MiB;
constexpr size_t WS_UPD = 400 * MiB;
constexpr size_t WS_ST = 464 * MiB;
constexpr size_t WS_END = 496 * MiB;

__device__ __forceinline__ unsigned f2bf(float f) { unsigned u = __builtin_bit_cast(unsigned, f); return (u + 0x7fffu + ((u >> 16) & 1u)) >> 16; }
__device__ __forceinline__ unsigned pk2(float lo, float hi) { return f2bf(lo) | (f2bf(hi) << 16); }
__device__ __forceinline__ float bf_lo(unsigned w) { return __builtin_bit_cast(float, w << 16); }
__device__ __forceinline__ float bf_hi(unsigned w) { return __builtin_bit_cast(float, w & 0xffff0000u); }
__device__ __forceinline__ float bf2f(bf16 h) { return __builtin_bit_cast(float, (unsigned)h << 16); }
__device__ __forceinline__ float wave_sum(float v) {
#pragma unroll
    for (int o = 1; o < 64; o <<= 1) v += __shfl_xor(v, o);
    return v;
}
__device__ __forceinline__ float silu_f(float g) { return g * __builtin_amdgcn_rcpf(1.0f + __expf(-g)); }

__device__ __forceinline__ void tr_item(const float* W, int K, int N, const float* kscale, bf16* WT, int dst_row0, LAS float* scr, int k0, int n0, int lane) {
    const int n4 = 4 * (lane & 7); const bool ok = (n0 + n4) < N;
#pragma unroll
    for (int i = 0; i < 8; ++i) { const int kk = 8 * i + (lane >> 3); f32x4 v = ok ? *(const f32x4*)(W + (size_t)(k0 + kk) * N + n0 + n4) : (f32x4){0.f, 0.f, 0.f, 0.f}; if (kscale) v = v * kscale[k0 + kk];
        scr[kk * 33 + n4] = v[0]; scr[kk * 33 + n4 + 1] = v[1]; scr[kk * 33 + n4 + 2] = v[2]; scr[kk * 33 + n4 + 3] = v[3]; }
    LDS_WAIT(); asm volatile("" ::: "memory");
    const int c = lane & 7;
#pragma unroll
    for (int j = 0; j < 4; ++j) { const int n = (lane >> 3) + 8 * j; const LAS float* s = scr + (8 * c) * 33 + n;
        u32x4 o; o.x = pk2(s[0 * 33], s[1 * 33]); o.y = pk2(s[2 * 33], s[3 * 33]); o.z = pk2(s[4 * 33], s[5 * 33]); o.w = pk2(s[6 * 33], s[7 * 33]);
        *(u32x4*)(WT + (size_t)(dst_row0 + n) * K + k0 + 8 * c) = o; }
    LDS_WAIT(); asm volatile("" ::: "memory");
}

struct Args { const float* in[17]; float* out; unsigned char* ws; int ph_lo, ph_hi; };

__device__ __forceinline__ void prologue(const Args& a, LAS unsigned char* lds, int wave, int lane) {
    unsigned char* ws = a.ws;
    LAS float* scr = (LAS float*)(lds + wave * 16384);
    const int gw = blockIdx.x * NWAVES + wave, NGW = gridDim.x * NWAVES;
    constexpr int I_W1 = (D / 64) * (NFF / 32), I_W2 = (DFF / 64) * (D / 32), I_WIN = (D / 64) * (NPROJ / 32), I_WOUT = (D / 64) * (D / 32);
    constexpr int I_L = 2 * I_W1 + 2 * I_W2 + I_WIN + I_WOUT;
    for (int it = gw; it < DEPTH * I_L; it += NGW) {
        const int l = it / I_L; int r = it % I_L;
        unsigned char* wl = ws + WS_W + (size_t)l * W_L;
        if (r < 2 * I_W1) {
            const bool second = r >= I_W1; if (second) r -= I_W1;
            const float* W = a.in[second ? 14 : 2] + (size_t)l * D * NFF; const float* ks = a.in[second ? 13 : 1] + (size_t)l * D;
            const int nblk = NFF / 32, kb = r / nblk, nb = r % nblk, n0 = 32 * nb;
            const int dst = n0 < DFF ? (n0 / 128) * 256 + (n0 % 128) : ((n0 - DFF) / 128) * 256 + 128 + ((n0 - DFF) % 128);
            tr_item(W, D, NFF, ks, (bf16*)(wl + (second ? W3_OFF : W1_OFF)), dst, scr, 64 * kb, n0, lane);
            continue;
        }
        r -= 2 * I_W1;
        if (r < 2 * I_W2) {
            const bool second = r >= I_W2; if (second) r -= I_W2;
            const float* W = a.in[second ? 15 : 3] + (size_t)l * DFF * D;
            const int nblk = D / 32, kb = r / nblk, nb = r % nblk;
            tr_item(W, DFF, D, nullptr, (bf16*)(wl + (second ? W4_OFF : W2_OFF)), 32 * nb, scr, 64 * kb, 32 * nb, lane);
            continue;
        }
        r -= 2 * I_W2;
        if (r < I_WIN) {
            const float* W = a.in[5] + (size_t)l * D * INCOLS; const float* ks = a.in[4] + (size_t)l * D;
            const int nblk = NPROJ / 32, kb = r / nblk, nb = r % nblk;
            tr_item(W, D, INCOLS, ks, (bf16*)(wl + WIN_OFF), 32 * nb, scr, 64 * kb, 32 * nb, lane);
            continue;
        }
        r -= I_WIN;
        {
            const float* W = a.in[12] + (size_t)l * D * D;
            const int nblk = D / 32, kb = r / nblk, nb = r % nblk;
            tr_item(W, D, D, nullptr, (bf16*)(wl + WOUT_OFF), 32 * nb, scr, 64 * kb, 32 * nb, lane);
        }
    }
    const int gt = blockIdx.x * NTHREADS + threadIdx.x, NGT = gridDim.x * NTHREADS;
    { const float* wsrc = a.in[7]; bf16* wsb = (bf16*)(ws + WS_WSB);
      for (int e = gt; e < DEPTH * 8 * 128 * 128; e += NGT) { const int s = e & 127, t = (e >> 7) & 127; const float v = ((t >> 6) >= (s >> 6)) ? wsrc[e] : 0.f; wsb[e] = (bf16)f2bf(v); } }
    { u64* rs = (u64*)(ws + WS_ROWSS) + M; for (int e = gt; e < 8 * M; e += NGT) rs[e] = 0ull; }
    { const float* x = a.in[0]; bf16* XN = (bf16*)(ws + WS_XN); u64* rs0 = (u64*)(ws + WS_ROWSS);
      for (int m = 2 * gw; m < M; m += 2 * NGW) {
          const f32x4* xr = (const f32x4*)(x + (size_t)m * D) + lane; f32x4 v[2][4]; float s[2] = {0.f, 0.f};
#pragma unroll
          for (int r = 0; r < 2; ++r)
#pragma unroll
              for (int j = 0; j < 4; ++j) v[r][j] = xr[r * (D / 4) + 64 * j];
#pragma unroll
          for (int r = 0; r < 2; ++r) {
#pragma unroll
              for (int j = 0; j < 4; ++j) s[r] += (v[r][j][0] * v[r][j][0] + v[r][j][1] * v[r][j][1]) + (v[r][j][2] * v[r][j][2] + v[r][j][3] * v[r][j][3]);
              s[r] = wave_sum(s[r]); if (lane == 0) rs0[m + r] = ss_fix(s[r]);
              u32x2* o = (u32x2*)(XN + (size_t)(m + r) * D) + lane;
#pragma unroll
              for (int j = 0; j < 4; ++j) { u32x2 w; w.x = pk2(v[r][j][0], v[r][j][1]); w.y = pk2(v[r][j][2], v[r][j][3]); o[64 * j] = w; }
          }
      } }
}

__device__ __forceinline__ void rank_unit(const bf16* XN, const bf16* WrT, const u64* rowss, float* R, int m0, int lane) {
    const int fr = lane & 15, fq = lane >> 4;
    const bf16* ap = XN + (size_t)(m0 + fr) * D + 8 * fq; const bf16* bp = WrT + (size_t)fr * D + 8 * fq;
    f32x4 acc0 = (f32x4){0.f, 0.f, 0.f, 0.f}, acc1 = (f32x4){0.f, 0.f, 0.f, 0.f};
#pragma unroll 8
    for (int ki = 0; ki < 32; ki += 2) {
        const bf16x8 a0 = *(const bf16x8*)(ap + 32 * ki), b0 = *(const bf16x8*)(bp + 32 * ki), a1 = *(const bf16x8*)(ap + 32 * ki + 32), b1 = *(const bf16x8*)(bp + 32 * ki + 32);
        acc0 = __builtin_amdgcn_mfma_f32_16x16x32_bf16(b0, a0, acc0, 0, 0, 0);
        acc1 = __builtin_amdgcn_mfma_f32_16x16x32_bf16(b1, a1, acc1, 0, 0, 0);
    }
    { const int row = m0 + fr; const float rs = __builtin_amdgcn_rsqf(ss_val(rowss[row]) * (1.f / D) + EPS); *(f32x4*)(R + (size_t)row * 16 + 4 * fq) = (acc0 + acc1) * rs; }
}

template <int HF>
__device__ __forceinline__ void gmlp_half(LAS unsigned char* wl, const bf16* PROJ, const bf16* wsg, const float* norm_v, const float* b_s, bf16* Y, int tok0, int g, int fr, int fq) {
    constexpr int VS = 136, NK = HF ? 4 : 2;
    bf16x8 bw[NK][4];
#pragma unroll
    for (int ki = 0; ki < NK; ++ki)
#pragma unroll
        for (int nt = 0; nt < 4; ++nt) bw[ki][nt] = *(const bf16x8*)(wsg + (size_t)(64 * HF + 16 * nt + fr) * 128 + 32 * ki + 8 * fq);
    f32x4 acc[4][4];
#pragma unroll
    for (int i = 0; i < 4; ++i)
#pragma unroll
        for (int j = 0; j < 4; ++j) acc[i][j] = (f32x4){0.f, 0.f, 0.f, 0.f};
#pragma unroll
    for (int ki = 0; ki < NK; ++ki) {
        bf16x8 av[4];
#pragma unroll
        for (int mi = 0; mi < 4; ++mi) av[mi] = *(const LAS bf16x8*)(wl + ((32 * (mi >> 1) + 8 * (fr >> 2) + 4 * (mi & 1) + (fr & 3)) * VS + 32 * ki + 8 * fq) * 2);
#pragma unroll
        for (int nt = 0; nt < 4; ++nt)
#pragma unroll
            for (int mi = 0; mi < 4; ++mi) acc[mi][nt] = __builtin_amdgcn_mfma_f32_16x16x32_bf16(av[mi], bw[ki][nt], acc[mi][nt], 0, 0, 0);
    }
    asm volatile("" ::: "memory");
    f32x4 nv[2][2];
#pragma unroll
    for (int p = 0; p < 2; ++p) { nv[p][0] = *(const f32x4*)(norm_v + g * 64 + 32 * p + 8 * fq); nv[p][1] = *(const f32x4*)(norm_v + g * 64 + 32 * p + 8 * fq + 4); }
#pragma unroll
    for (int nt = 0; nt < 4; ++nt) {
        const int t = 64 * HF + 16 * nt + fr; const size_t tok = (size_t)(tok0 + t); const float bs = b_s[g * 128 + t];
        u32x4 uu[2];
#pragma unroll
        for (int p = 0; p < 2; ++p) uu[p] = *(const u32x4*)(PROJ + tok * NPROJ + g * 64 + 32 * p + 8 * fq);
#pragma unroll
        for (int p = 0; p < 2; ++p) {
            u32x4 w;
#pragma unroll
            for (int e2 = 0; e2 < 2; ++e2) {
                const f32x4 z = nv[p][e2] * acc[2 * p + e2][nt] + bs;
                const unsigned u0 = uu[p][2 * e2], u1 = uu[p][2 * e2 + 1];
                w[2 * e2] = pk2(bf_lo(u0) * z[0], bf_hi(u0) * z[1]); w[2 * e2 + 1] = pk2(bf_lo(u1) * z[2], bf_hi(u1) * z[3]);
            }
            *(u32x4*)(Y + tok * D + g * 64 + 32 * p + 8 * fq) = w;
        }
    }
}
__device__ __forceinline__ void gmlp_unit(LAS unsigned char* wl, const bf16* PROJ, const u64* rowss_v, const bf16* wsb, const float* norm_v, const float* b_s, bf16* Y, int nb, int g, int lane) {
    constexpr int VS = 136;
    LAS unsigned* VT32 = (LAS unsigned*)wl;
    const int tok0 = nb * 128, sp = lane >> 3, cc = lane & 7;
#pragma unroll 4
    for (int it = 0; it < 8; ++it) {
        const int s0 = it * 16 + 2 * sp;
        const float r0 = __builtin_amdgcn_rsqf(ss_val(rowss_v[tok0 + s0]) * (1.f / 512.f) + EPS), r1 = __builtin_amdgcn_rsqf(ss_val(rowss_v[tok0 + s0 + 1]) * (1.f / 512.f) + EPS);
        const u32x4 va = *(const u32x4*)(PROJ + (size_t)(tok0 + s0) * NPROJ + 512 + g * 64 + 8 * cc);
        const u32x4 vb = *(const u32x4*)(PROJ + (size_t)(tok0 + s0 + 1) * NPROJ + 512 + g * 64 + 8 * cc);
#pragma unroll
        for (int i = 0; i < 4; ++i) {
            VT32[(8 * cc + 2 * i) * (VS / 2) + (s0 >> 1)] = pk2(bf_lo(va[i]) * r0, bf_lo(vb[i]) * r1);
            VT32[(8 * cc + 2 * i + 1) * (VS / 2) + (s0 >> 1)] = pk2(bf_hi(va[i]) * r0, bf_hi(vb[i]) * r1);
        }
    }
    LDS_WAIT(); asm volatile("" ::: "memory");
    const int fr = lane & 15, fq = lane >> 4;
    const bf16* wsg = wsb + (size_t)g * 128 * 128;
    gmlp_half<0>(wl, PROJ, wsg, norm_v, b_s, Y, tok0, g, fr, fq);
    gmlp_half<1>(wl, PROJ, wsg, norm_v, b_s, Y, tok0, g, fr, fq);
    LDS_WAIT(); asm volatile("" ::: "memory");
}

__device__ __forceinline__ void gla_upd_unit(LAS unsigned char* wl, const bf16* PROJ, const float* R, const float* w_gk2, const float* b_gk, float* UPD, float* DEC, int unit, int lane) {
    constexpr int KS = 72;
    LAS unsigned* KD32 = (LAS unsigned*)wl; LAS unsigned* VB32 = (LAS unsigned*)(wl + 9216);
    const int h = unit & 3, tok0 = (unit >> 2) * 64, kk = lane;
    { const f32x4* rp = (const f32x4*)(R + (size_t)(tok0 + lane) * 16); LAS f32x4* rl = (LAS f32x4*)(wl + 9216) + lane * 4;
      const f32x4 r0 = rp[0], r1 = rp[1], r2 = rp[2], r3 = rp[3]; rl[0] = r0; rl[1] = r1; rl[2] = r2; rl[3] = r3; }
    const bf16* kp = PROJ + (size_t)tok0 * NPROJ + 1280 + h * 64 + kk;
    unsigned short kv0[32], kv1[32];
#pragma unroll
    for (int t = 0; t < 32; ++t) kv0[t] = kp[(size_t)t * NPROJ];
    float w[16];
#pragma unroll
    for (int j = 0; j < 16; ++j) w[j] = w_gk2[j * 256 + h * 64 + kk];
    const float bias = b_gk[h * 64 + kk];
    LDS_WAIT(); asm volatile("" ::: "memory");
    float la[64]; float tot = 0.f;
#pragma unroll
    for (int t = 0; t < 64; ++t) {
        const LAS f32x4* rr = (const LAS f32x4*)(wl + 9216) + t * 4;
        float z = bias;
#pragma unroll
        for (int q = 0; q < 4; ++q) { const f32x4 rv = rr[q]; z += rv[0] * w[4 * q] + rv[1] * w[4 * q + 1] + rv[2] * w[4 * q + 2] + rv[3] * w[4 * q + 3]; }
        la[t] = (fminf(z, 0.f) - __logf(1.0f + __expf(-fabsf(z)))) * (1.0f / 16.0f);
        tot += la[t];
    }
    DEC[(size_t)unit * 64 + kk] = __expf(tot);
#pragma unroll
    for (int t = 0; t < 32; ++t) kv1[t] = kp[(size_t)(t + 32) * NPROJ];
    float run = 0.f;
#pragma unroll
    for (int t = 0; t < 32; t += 2) {
        run += la[t]; const float d0 = bf2f(kv0[t]) * __expf(tot - run);
        run += la[t + 1]; const float d1 = bf2f(kv0[t + 1]) * __expf(tot - run);
        KD32[kk * (KS / 2) + (t >> 1)] = pk2(d0, d1);
    }
#pragma unroll
    for (int t = 0; t < 32; t += 2) {
        run += la[32 + t]; const float d0 = bf2f(kv1[t]) * __expf(tot - run);
        run += la[33 + t]; const float d1 = bf2f(kv1[t + 1]) * __expf(tot - run);
        KD32[kk * (KS / 2) + 16 + (t >> 1)] = pk2(d0, d1);
    }
    LDS_WAIT(); asm volatile("" ::: "memory");
    const int fr = lane & 15, fq = lane >> 4, sp = lane >> 3, cc = lane & 7;
#pragma unroll 1
    for (int vh = 0; vh < 2; ++vh) {
#pragma unroll
        for (int it = 0; it < 4; ++it) {
            const int t0 = it * 16 + 2 * sp;
            const u32x4 va = *(const u32x4*)(PROJ + (size_t)(tok0 + t0) * NPROJ + 1536 + h * 128 + vh * 64 + 8 * cc);
            const u32x4 vb = *(const u32x4*)(PROJ + (size_t)(tok0 + t0 + 1) * NPROJ + 1536 + h * 128 + vh * 64 + 8 * cc);
#pragma unroll
            for (int i = 0; i < 4; ++i) {
                VB32[(8 * cc + 2 * i) * (KS / 2) + (t0 >> 1)] = (va[i] & 0xffffu) | (vb[i] << 16);
                VB32[(8 * cc + 2 * i + 1) * (KS / 2) + (t0 >> 1)] = (va[i] >> 16) | (vb[i] & 0xffff0000u);
            }
        }
        LDS_WAIT(); asm volatile("" ::: "memory");
        f32x4 acc[4][4];
#pragma unroll
        for (int i = 0; i < 4; ++i)
#pragma unroll
            for (int j = 0; j < 4; ++j) acc[i][j] = (f32x4){0.f, 0.f, 0.f, 0.f};
#pragma unroll
        for (int ki = 0; ki < 2; ++ki) {
            bf16x8 av[4], bk[4];
#pragma unroll
            for (int mi = 0; mi < 4; ++mi) av[mi] = *(const LAS bf16x8*)(wl + 9216 + ((16 * mi + fr) * KS + 32 * ki + 8 * fq) * 2);
#pragma unroll
            for (int ni = 0; ni < 4; ++ni) bk[ni] = *(const LAS bf16x8*)(wl + ((16 * ni + fr) * KS + 32 * ki + 8 * fq) * 2);
#pragma unroll
            for (int mi = 0; mi < 4; ++mi)
#pragma unroll
                for (int ni = 0; ni < 4; ++ni) acc[mi][ni] = __builtin_amdgcn_mfma_f32_16x16x32_bf16(bk[ni], av[mi], acc[mi][ni], 0, 0, 0);
        }
        float* up = UPD + (size_t)unit * 8192 + (size_t)(vh * 64) * 64;
#pragma unroll
        for (int mi = 0; mi < 4; ++mi)
#pragma unroll
            for (int ni = 0; ni < 4; ++ni) *(f32x4*)(up + (16 * mi + fr) * 64 + 16 * ni + 4 * fq) = acc[mi][ni];
        LDS_WAIT(); asm volatile("" ::: "memory");
    }
}

__device__ __forceinline__ void gla_scan(const float* UPD, const float* DEC, bf16* ST, int gtid, int gthreads) {
    for (int p = gtid; p < 4 * 128 * 16; p += gthreads) {
        const int h = p >> 11, rem = p & 2047, v = rem >> 4, kq = rem & 15;
        f32x4 s = (f32x4){0.f, 0.f, 0.f, 0.f};
#pragma unroll 1
        for (int c0 = 0; c0 < 64; c0 += 16) {
            f32x4 dv[16], uv[16];
#pragma unroll
            for (int i = 0; i < 16; ++i) { const size_t unit = (size_t)((c0 + i) * 4 + h); dv[i] = *(const f32x4*)(DEC + unit * 64 + 4 * kq); uv[i] = *(const f32x4*)(UPD + unit * 8192 + v * 64 + 4 * kq); }
            asm volatile("" : "+v"(dv[0]), "+v"(dv[1]), "+v"(dv[2]), "+v"(dv[3]), "+v"(dv[4]), "+v"(dv[5]), "+v"(dv[6]), "+v"(dv[7]) :: "memory");
            asm volatile("" : "+v"(dv[8]), "+v"(dv[9]), "+v"(dv[10]), "+v"(dv[11]), "+v"(dv[12]), "+v"(dv[13]), "+v"(dv[14]), "+v"(dv[15]) :: "memory");
            asm volatile("" : "+v"(uv[0]), "+v"(uv[1]), "+v"(uv[2]), "+v"(uv[3]), "+v"(uv[4]), "+v"(uv[5]), "+v"(uv[6]), "+v"(uv[7]) :: "memory");
            asm volatile("" : "+v"(uv[8]), "+v"(uv[9]), "+v"(uv[10]), "+v"(uv[11]), "+v"(uv[12]), "+v"(uv[13]), "+v"(uv[14]), "+v"(uv[15]) :: "memory");
#pragma unroll
            for (int i = 0; i < 16; ++i) {
                const size_t unit = (size_t)((c0 + i) * 4 + h);
                s = dv[i] * s + uv[i];
                u32x2 w; w.x = pk2(s[0], s[1]); w.y = pk2(s[2], s[3]);
                *(u32x2*)(ST + unit * 8192 + v * 64 + 4 * kq) = w;
            }
        }
    }
}

__device__ __forceinline__ void gla_out_unit(const bf16* PROJ, const bf16* ST, const float* norm_o, bf16* Y, int unit, int lane) {
    const int h = unit & 3, tok0 = (unit >> 2) * 64, fr = lane & 15, fq = lane >> 4;
    f32x4 acc[8][4];
#pragma unroll
    for (int i = 0; i < 8; ++i)
#pragma unroll
        for (int j = 0; j < 4; ++j) acc[i][j] = (f32x4){0.f, 0.f, 0.f, 0.f};
    const bf16* st = ST + (size_t)unit * 8192;
#pragma unroll 1
    for (int ki = 0; ki < 2; ++ki) {
        bf16x8 bq[4], as[8];
#pragma unroll
        for (int ni = 0; ni < 4; ++ni) bq[ni] = *(const bf16x8*)(PROJ + (size_t)(tok0 + 16 * ni + fr) * NPROJ + 1024 + h * 64 + 32 * ki + 8 * fq);
#pragma unroll
        for (int mi = 0; mi < 8; ++mi) as[mi] = *(const bf16x8*)(st + (16 * mi + fr) * 64 + 32 * ki + 8 * fq);
        asm volatile("" : "+v"(as[0]), "+v"(as[1]), "+v"(as[2]), "+v"(as[3]), "+v"(as[4]), "+v"(as[5]), "+v"(as[6]), "+v"(as[7]), "+v"(bq[0]), "+v"(bq[1]), "+v"(bq[2]), "+v"(bq[3]));
#pragma unroll
        for (int mi = 0; mi < 8; ++mi)
#pragma unroll
            for (int ni = 0; ni < 4; ++ni) acc[mi][ni] = __builtin_amdgcn_mfma_f32_16x16x32_bf16(as[mi], bq[ni], acc[mi][ni], 0, 0, 0);
    }
    f32x4 nov[8];
#pragma unroll
    for (int mi = 0; mi < 8; ++mi) nov[mi] = *(const f32x4*)(norm_o + h * 128 + 16 * mi + 4 * fq);
#pragma unroll
    for (int ni = 0; ni < 4; ++ni) {
        u32x2 gg1[8];
#pragma unroll
        for (int mi = 0; mi < 8; ++mi) gg1[mi] = *(const u32x2*)(PROJ + (size_t)(tok0 + 16 * ni + fr) * NPROJ + 2048 + h * 128 + 16 * mi + 4 * fq);
        asm volatile("" : "+v"(gg1[0]), "+v"(gg1[1]), "+v"(gg1[2]), "+v"(gg1[3]), "+v"(gg1[4]), "+v"(gg1[5]), "+v"(gg1[6]), "+v"(gg1[7]));
        float ss = 0.f;
#pragma unroll
        for (int mi = 0; mi < 8; ++mi) { acc[mi][ni] = acc[mi][ni] * 0.125f; const f32x4 o = acc[mi][ni]; ss += (o[0] * o[0] + o[1] * o[1]) + (o[2] * o[2] + o[3] * o[3]); }
        ss += __shfl_xor(ss, 16); ss += __shfl_xor(ss, 32);
        const float rs = __builtin_amdgcn_rsqf(ss * (1.f / 128.f) + EPS);
        const size_t tok = (size_t)(tok0 + 16 * ni + fr);
#pragma unroll
        for (int mi = 0; mi < 8; ++mi) {
            const int v = h * 128 + 16 * mi + 4 * fq;
            const f32x4 no = nov[mi]; const u32x2 g2 = gg1[mi];
            const f32x4 o = acc[mi][ni];
            const float y0 = o[0] * rs * no[0] * silu_f(bf_lo(g2.x)), y1 = o[1] * rs * no[1] * silu_f(bf_hi(g2.x));
            const float y2 = o[2] * rs * no[2] * silu_f(bf_lo(g2.y)), y3 = o[3] * rs * no[3] * silu_f(bf_hi(g2.y));
            u32x2 w; w.x = pk2(y0, y1); w.y = pk2(y2, y3);
            *(u32x2*)(Y + tok * D + 512 + v) = w;
        }
    }
}

#define XB_TMO      128
#define XB_XCNT(j)  (256  + 64 * (j))
#define XB_XSUB(j)  (1280 + 64 * (j))
#define XB_XGEN(j)  (2304 + 64 * (j))
#define XB_TOP      3328
#define XB_TOPGEN   3392
#define XCD_BAR_WORDS 3456
#define XB_SPIN_CAP (1u << 18)

__device__ __forceinline__ unsigned xb_ld(unsigned* p)              { return __hip_atomic_load(p, __ATOMIC_RELAXED, __HIP_MEMORY_SCOPE_AGENT); }
__device__ __forceinline__ unsigned xb_add(unsigned* p, unsigned v) { return __hip_atomic_fetch_add(p, v, __ATOMIC_RELAXED, __HIP_MEMORY_SCOPE_AGENT); }
__device__ __forceinline__ unsigned xb_xcc_id() { return (unsigned)__builtin_amdgcn_s_getreg((3 << 11) | 20) & 0xFu; }
#define XB_SPIN(cond, bar) do { unsigned _sp = 0; while (cond) { __builtin_amdgcn_s_sleep(1); \
    if ((++_sp & 255u) == 0u) { if (xb_ld(&(bar)[XB_TMO])) break; if (_sp > XB_SPIN_CAP) { atomicAdd(&(bar)[XB_TMO], 1u); break; } } } } while (0)

struct XcdBarrier {
    unsigned* bar; unsigned x; unsigned gsz;
    volatile LAS unsigned* st;
};

__device__ __forceinline__ XcdBarrier xcd_barrier_post(unsigned* bar, volatile LAS unsigned* st, unsigned gsz) {
    XcdBarrier b; b.bar = bar; b.x = xb_xcc_id(); b.st = st; b.gsz = gsz;
    if (threadIdx.x == 0) (void)xb_add(&bar[XB_XCNT(b.x)], 1u);
    return b;
}
__device__ __forceinline__ void xcd_barrier_complete(unsigned* bar, unsigned x, unsigned G, unsigned& nloc, unsigned& nx) {
    unsigned sum, cnt, mine, sp = 0u;
    for (;;) {
        sum = 0u; cnt = 0u; mine = 0u;
#pragma unroll
        for (unsigned j = 0; j < 16; ++j) { const unsigned c = xb_ld(&bar[XB_XCNT(j)]); sum += c; cnt += (c > 0u) ? 1u : 0u; mine = (j == x) ? c : mine; }
        if (sum == G) break;
        __builtin_amdgcn_s_sleep(1);
        if ((++sp & 255u) == 0u) { if (xb_ld(&bar[XB_TMO])) break; if (sp > XB_SPIN_CAP) { atomicAdd(&bar[XB_TMO], 1u); break; } }
    }
    nloc = mine > 0u ? mine : 1u; nx = cnt > 0u ? cnt : 1u;
}

__device__ __forceinline__ void xcd_barrier(const XcdBarrier& b) {
    asm volatile("s_waitcnt vmcnt(0)" ::: "memory");
    __syncthreads();
    if (threadIdx.x == 0) {
        unsigned* bar = b.bar;
        __builtin_amdgcn_s_waitcnt(0);
        unsigned nloc = b.st[0], nx = b.st[1];
        if (nloc == 0u) { xcd_barrier_complete(bar, b.x, b.gsz, nloc, nx); b.st[0] = nloc; b.st[1] = nx; }
        const unsigned old = xb_add(&bar[XB_XSUB(b.x)], 1u);
        const unsigned gen = old / nloc;
        if (old + 1u == (gen + 1u) * nloc) {
            __builtin_amdgcn_fence(__ATOMIC_RELEASE, "agent");
            asm volatile("s_waitcnt vmcnt(0)" ::: "memory");
            const unsigned og = xb_add(&bar[XB_TOP], 1u);
            const unsigned tg = og / nx;
            if (og + 1u == (tg + 1u) * nx) xb_add(&bar[XB_TOPGEN], 1u);
            else XB_SPIN(xb_ld(&bar[XB_TOPGEN]) == tg, bar);
            __builtin_amdgcn_fence(__ATOMIC_ACQUIRE, "agent");
            xb_add(&bar[XB_XGEN(b.x)], 1u);
            asm volatile("s_waitcnt vmcnt(0)" ::: "memory");
        } else {
            XB_SPIN(xb_ld(&bar[XB_XGEN(b.x)]) == gen, bar);
            __builtin_amdgcn_fence(__ATOMIC_ACQUIRE, "agent");
            asm volatile("s_waitcnt vmcnt(0)" ::: "memory");
        }
    }
    __syncthreads();
}

#define IN(k) (lo <= (k) && (k) < hi)
#define SEAM(k) do { if (IN(k) && IN((k) + 1)) xcd_barrier(bar); } while (0)
template <int L>
__device__ __forceinline__ void layer(const Args& a, LAS unsigned char* lds, const XcdBarrier& bar, int lo, int hi, int wave, int lane, int b, int r, int GS) {
    constexpr int P = 1 + 9 * L;
    const int gw = r * NWAVES + wave, NGW = GS * NWAVES;
    const size_t tb = (size_t)b * SEQ;
    unsigned char* ws = a.ws;
    u64* rowss = (u64*)(ws + WS_ROWSS) + tb;
    bf16* XN = (bf16*)(ws + WS_XN) + tb * D; bf16* HB = (bf16*)(ws + WS_H) + tb * NPROJ; bf16* YB = (bf16*)(ws + WS_Y) + tb * D;
    float* RB = (float*)(ws + WS_R) + tb * 16;
    float* UPD = (float*)(ws + WS_UPD) + (size_t)b * 256 * 8192; float* DEC = (float*)(ws + WS_DEC) + (size_t)b * 256 * 64; bf16* ST = (bf16*)(ws + WS_ST) + (size_t)b * 256 * 8192;
    unsigned char* wl = ws + WS_W + (size_t)L * W_L;
    if (IN(P + 0)) {
        pg8::Gemm g{XN, (const bf16*)(wl + W1_OFF), SEQ, NFF, D}; pg8::GroupOrder S; S.init(SEQ, NFF, GS, r);
        pg8::EpiSwiglu E{HB, DFF, rowss + (size_t)(3 * L + 0) * M, 1.f / D, EPS};
        pg8::gemm_phase<pg8::EpiSwiglu, pg8::GroupOrder, true, true>(lds, g, S, E);
    }
    SEAM(P + 0);
    if (IN(P + 1)) {
        pg8::Gemm g{HB, (const bf16*)(wl + W2_OFF), SEQ, D, DFF}; pg8::GroupOrder S; S.init(SEQ, D, GS, r);
        pg8::EpiResid E{L == 0 ? a.in[0] + tb * D : nullptr, XN, rowss + (size_t)(3 * L + 1) * M, 0.5f, D};
        pg8::gemm_phase<pg8::EpiResid, pg8::GroupOrder, true, true>(lds, g, S, E);
    }
    SEAM(P + 1);
    if (IN(P + 2)) {
        pg8::Gemm g{XN, (const bf16*)(wl + WIN_OFF), SEQ, 2560, D}; pg8::GroupOrder S; S.init(SEQ, 2560, GS, r);
        pg8::EpiProj E{HB, NPROJ, rowss + (size_t)(3 * L + 1) * M, rowss + (size_t)(7 + L) * M, RB, 1.f / D, EPS};
        pg8::gemm_phase<pg8::EpiProj, pg8::GroupOrder, true, true>(lds, g, S, E);
        for (int u = gw; u < SEQ / 16; u += NGW) rank_unit(XN, (const bf16*)(wl + WIN_OFF) + (size_t)2560 * D, rowss + (size_t)(3 * L + 1) * M, RB, u * 16, lane);
    }
    SEAM(P + 2);
    if (IN(P + 3)) {
        LAS unsigned char* wlds = lds + wave * WAVE_LDS;
        for (int u = gw; u < 256; u += NGW)
            gmlp_unit(wlds, HB, rowss + (size_t)(7 + L) * M, (const bf16*)(ws + WS_WSB) + (size_t)L * 8 * 128 * 128, a.in[6] + L * 512, a.in[8] + L * 1024, YB, u >> 3, u & 7, lane);
        for (int u = gw; u < 256; u += NGW)
            gla_upd_unit(wlds, HB, RB, a.in[9] + L * 16 * 256, a.in[10] + L * 256, UPD, DEC, u, lane);
    }
    SEAM(P + 3);
    if (IN(P + 4)) { if (threadIdx.x < NTHREADS / 2) gla_scan(UPD, DEC, ST, r * (NTHREADS / 2) + (int)threadIdx.x, GS * (NTHREADS / 2)); }
    SEAM(P + 4);
    if (IN(P + 5)) { for (int u = gw; u < 256; u += NGW) gla_out_unit(HB, ST, a.in[11] + L * 512, YB, u, lane); }
    SEAM(P + 5);
    if (IN(P + 6)) {
        pg8::Gemm g{YB, (const bf16*)(wl + WOUT_OFF), SEQ, D, D}; pg8::GroupOrder S; S.init(SEQ, D, GS, r);
        pg8::EpiResid E{nullptr, XN, rowss + (size_t)(3 * L + 2) * M, 1.0f, D};
        pg8::gemm_phase<pg8::EpiResid, pg8::GroupOrder, true, true>(lds, g, S, E);
    }
    SEAM(P + 6);
    if (IN(P + 7)) {
        pg8::Gemm g{XN, (const bf16*)(wl + W3_OFF), SEQ, NFF, D}; pg8::GroupOrder S; S.init(SEQ, NFF, GS, r);
        pg8::EpiSwiglu E{HB, DFF, rowss + (size_t)(3 * L + 2) * M, 1.f / D, EPS};
        pg8::gemm_phase<pg8::EpiSwiglu, pg8::GroupOrder, true, true>(lds, g, S, E);
    }
    SEAM(P + 7);
    if (IN(P + 8)) {
        pg8::Gemm g{HB, (const bf16*)(wl + W4_OFF), SEQ, D, DFF}; pg8::GroupOrder S; S.init(SEQ, D, GS, r);
        pg8::EpiResid E{nullptr, XN, rowss + (size_t)(3 * L + 3) * M, 0.5f, D};
        pg8::gemm_phase<pg8::EpiResid, pg8::GroupOrder, true, true>(lds, g, S, E);
    }
    SEAM(P + 8);
}

__global__ void __launch_bounds__(NTHREADS, 2) fwd(Args a) {
    extern __shared__ __attribute__((aligned(16))) unsigned char lds_raw[];
    LAS unsigned char* lds = (LAS unsigned char*)lds_raw;
    const int tid = threadIdx.x, lane = tid & 63, wave = __builtin_amdgcn_readfirstlane(tid >> 6);
    const int lo = a.ph_lo, hi = a.ph_hi;
    if (tid < 64) ((LAS unsigned*)(lds + MISC_OFF))[tid] = 0u;
    __syncthreads();
    const int G = gridDim.x, GS = G / NGRP, b = (int)blockIdx.x % NGRP, r = (int)blockIdx.x / NGRP;
    const bool in_group = r < GS;
    XcdBarrier gbar = xcd_barrier_post((unsigned*)a.ws + NGRP * XCD_BAR_WORDS, (volatile LAS unsigned*)(lds + MISC_OFF), (unsigned)G);
    XcdBarrier bar = gbar;
    if (in_group) bar = xcd_barrier_post((unsigned*)a.ws + b * XCD_BAR_WORDS, (volatile LAS unsigned*)(lds + MISC_OFF) + 2, (unsigned)GS);
    if (IN(0)) prologue(a, lds, wave, lane);
    if (lo < 0) cg::this_grid().sync();
    if (IN(0) && IN(1)) xcd_barrier(gbar);
    if (!in_group) return;
    layer<0>(a, lds, bar, lo, hi, wave, lane, b, r, GS);
    layer<1>(a, lds, bar, lo, hi, wave, lane, b, r, GS);
    if (IN(NPHASE - 1)) {
        const int gw = r * NWAVES + wave, NGW = GS * NWAVES; const size_t tb = (size_t)b * SEQ;
        const float* fw = a.in[16]; const u64* rs6 = (const u64*)(a.ws + WS_ROWSS) + (size_t)6 * M + tb; const bf16* XN = (const bf16*)(a.ws + WS_XN) + tb * D; float* outb = a.out + tb * D;
        f32x4 wv[2][2];
#pragma unroll
        for (int j = 0; j < 2; ++j) { wv[j][0] = *((const f32x4*)fw + 2 * (lane + 64 * j)); wv[j][1] = *((const f32x4*)fw + 2 * (lane + 64 * j) + 1); }
        for (int m = gw; m < SEQ; m += 2 * NGW) {
            const int m1 = m + NGW; const bool two = m1 < SEQ;
            u32x4 xv[2][2]; u64 sv[2];
            sv[0] = rs6[m]; sv[1] = two ? rs6[m1] : sv[0];
#pragma unroll
            for (int j = 0; j < 2; ++j) { xv[0][j] = *((const u32x4*)(XN + (size_t)m * D) + lane + 64 * j); xv[1][j] = two ? *((const u32x4*)(XN + (size_t)m1 * D) + lane + 64 * j) : xv[0][j]; }
            asm volatile("" : "+v"(xv[0][0]), "+v"(xv[0][1]), "+v"(xv[1][0]), "+v"(xv[1][1]), "+v"(sv[0]), "+v"(sv[1]) :: "memory");
#pragma unroll
            for (int r2 = 0; r2 < 2; ++r2) {
                if (r2 == 1 && !two) break;
                const float rs = __builtin_amdgcn_rsqf(ss_val(sv[r2]) * (1.f / D) + EPS);
                f32x4* orow = (f32x4*)(outb + (size_t)(r2 ? m1 : m) * D);
#pragma unroll
                for (int j = 0; j < 2; ++j) {
                    const u32x4 x4 = xv[r2][j]; const f32x4 w0 = wv[j][0], w1 = wv[j][1];
                    f32x4 o0, o1;
                    o0[0] = bf_lo(x4[0]) * rs * w0[0]; o0[1] = bf_hi(x4[0]) * rs * w0[1]; o0[2] = bf_lo(x4[1]) * rs * w0[2]; o0[3] = bf_hi(x4[1]) * rs * w0[3];
                    o1[0] = bf_lo(x4[2]) * rs * w1[0]; o1[1] = bf_hi(x4[2]) * rs * w1[1]; o1[2] = bf_lo(x4[3]) * rs * w1[2]; o1[3] = bf_hi(x4[3]) * rs * w1[3];
                    orow[2 * (lane + 64 * j)] = o0; orow[2 * (lane + 64 * j) + 1] = o1;
                }
            }
        }
    }
}

extern "C" void kernel_launch(void* const* d_in, const int* in_sizes, int n_in, void* d_out, int out_size, void* d_ws, size_t ws_size, hipStream_t stream) {
    static int grid = 0;
    if (grid == 0) {
        if (n_in != 17 || in_sizes[0] != M * D || out_size != M * D || ws_size < WS_END) { fprintf(stderr, "kernel_launch: unexpected problem (n_in %d, in0 %d, out %d, ws %zu)\n", n_in, n_in > 0 ? in_sizes[0] : -1, out_size, ws_size); grid = -1; return; }
        int dev = 0, cus = 0, per_cu = 0;
        (void)hipGetDevice(&dev); (void)hipDeviceGetAttribute(&cus, hipDeviceAttributeMultiprocessorCount, dev);
        if (hipFuncSetAttribute((const void*)fwd, hipFuncAttributeMaxDynamicSharedMemorySize, LDS_BYTES) != hipSuccess) { fprintf(stderr, "kernel_launch: hipFuncSetAttribute failed\n"); grid = -1; return; }
        if (hipOccupancyMaxActiveBlocksPerMultiprocessor(&per_cu, (const void*)fwd, NTHREADS, LDS_BYTES) != hipSuccess || per_cu < 1) { fprintf(stderr, "kernel_launch: occupancy query says %d\n", per_cu); per_cu = 1; }
        (void)hipGetLastError();
        grid = cus * per_cu;
    }
    if (grid < 0) return;
    if (hipMemsetAsync(d_ws, 0, 131072, stream) != hipSuccess) { fprintf(stderr, "kernel_launch: memset of the barrier words failed\n"); return; }
    Args a{};
    for (int i = 0; i < 17; ++i) a.in[i] = (const float*)d_in[i];
    a.out = (float*)d_out; a.ws = (unsigned char*)d_ws;
#if MK_MULTI
#ifndef DUPMASK
#define DUPMASK 0
#endif
    for (int ph = 0; ph < NPHASE; ++ph) { a.ph_lo = ph; a.ph_hi = ph + 1; hipLaunchKernelGGL(fwd, dim3(grid), dim3(NTHREADS), LDS_BYTES, stream, a);
        const int bit = ph == 0 ? 9 : (ph == NPHASE - 1 ? 10 : (ph - 1) % 9);
        if ((DUPMASK >> bit) & 1) hipLaunchKernelGGL(fwd, dim3(grid), dim3(NTHREADS), LDS_BYTES, stream, a); }
#else
    a.ph_lo = 0; a.ph_hi = NPHASE;
    void* args[] = {&a};
    hipError_t e = hipLaunchCooperativeKernel((const void*)fwd, dim3(grid), dim3(NTHREADS), args, LDS_BYTES, stream);
    if (e != hipSuccess) fprintf(stderr, "cooperative launch failed: %s (grid %d)\n", hipGetErrorString(e), grid);
#endif
}
```
